# Optimizing an MI355X kernel written in HIP

```python
import jax, jax.numpy as jnp
from jax import lax
import numpy as np

D_MODEL = 1024
BATCH = 2
SEQ = 8192
DEPTH = 1
DEC_BATCH = 8
DEC_SEQ = 32
PAST_LEN = 4096

CHUNK = 64
D_MIX = D_MODEL
D_CONV = D_MIX // 2
D_RET = D_MIX - D_CONV
N_RET_HEADS = 4
HEAD_DIM = D_RET // N_RET_HEADS
CONV_WIDTH = 31
D_FF = 2816
ROPE_THETA = 10000.0
EPS = 1e-6
D_IN = 2 * D_CONV + 4 * D_RET

kernel_name = "hybrid_conformer_retention_stream_step"


def rmsnorm(x, g):
    xf = x.astype(jnp.float32)
    y = xf * lax.rsqrt(jnp.mean(xf * xf, axis=-1, keepdims=True) + EPS)
    return (y * g.astype(jnp.float32)).astype(x.dtype)


def layernorm(x, g, b):
    xf = x.astype(jnp.float32)
    mu = jnp.mean(xf, axis=-1, keepdims=True)
    var = jnp.mean(jnp.square(xf - mu), axis=-1, keepdims=True)
    y = (xf - mu) * lax.rsqrt(var + EPS)
    return (y * g.astype(jnp.float32) + b.astype(jnp.float32)).astype(x.dtype)


def swiglu(x, w_gate, w_up, w_down):
    return (jax.nn.silu(x @ w_gate) * (x @ w_up)) @ w_down


def rope(x, pos):
    half = HEAD_DIM // 2
    inv = ROPE_THETA ** (-jnp.arange(half, dtype=jnp.float32) / half)
    ang = pos.astype(jnp.float32)[:, None] * inv[None, :]
    cos, sin = jnp.cos(ang), jnp.sin(ang)
    x1 = x[..., :half].astype(jnp.float32)
    x2 = x[..., half:].astype(jnp.float32)
    out = jnp.concatenate([x1 * cos - x2 * sin, x2 * cos + x1 * sin], axis=-1)
    return out.astype(x.dtype)


def retention(q, k, v, R0):
    B, H, T, _ = q.shape
    C = min(T, CHUNK)
    n = T // C
    dt = q.dtype
    log_gamma = jnp.log1p(-jnp.exp2(-5.0 - jnp.arange(H, dtype=jnp.float32)))
    idx = jnp.arange(C, dtype=jnp.float32)
    rel = idx[:, None] - idx[None, :]
    decay_mask = jnp.where(rel >= 0,
                           jnp.exp(log_gamma[:, None, None] * jnp.maximum(rel, 0.0)),
                           0.0).astype(dt)
    xi = jnp.exp(log_gamma[:, None] * (idx + 1.0))[..., None].astype(dt)
    zeta = jnp.exp(log_gamma[:, None] * (C - 1.0 - idx))[..., None].astype(dt)
    g_chunk = jnp.exp(log_gamma * C)[:, None, None].astype(dt)

    def step(R, qkv):
        qc, kc, vc = qkv
        s = jnp.einsum('bhid,bhjd->bhij', qc, kc) * decay_mask
        o = (jnp.einsum('bhij,bhjv->bhiv', s, vc)
             + jnp.einsum('bhid,bhdv->bhiv', qc, R) * xi)
        R = R * g_chunk + jnp.einsum('bhjd,bhjv->bhdv', kc * zeta, vc)
        return R, o

    def split(t):
        return t.reshape(B, H, n, C, t.shape[-1]).transpose(2, 0, 1, 3, 4)

    R, o = lax.scan(step, R0.astype(dt), (split(q), split(k), split(v)))
    o = o.transpose(1, 2, 0, 3, 4).reshape(B, H, T, -1)
    return o, R


def mixer(h, conv_hist, R0, pos0, w_in, conv_w, conv_b, conv_ln_g, conv_ln_b,
          ret_gn_g, w_out):
    B, T, _ = h.shape
    p = h @ w_in
    a, b, q, k, v, g = jnp.split(
        p, [D_CONV, 2 * D_CONV, 2 * D_CONV + D_RET, 2 * D_CONV + 2 * D_RET,
            2 * D_CONV + 3 * D_RET], axis=-1)

    u = a * jax.nn.sigmoid(b)
    u_ext = jnp.concatenate([conv_hist.astype(u.dtype), u], axis=1)
    c = lax.conv_general_dilated(
        u_ext, conv_w[:, None, :].astype(u.dtype), window_strides=(1,), padding='VALID',
        dimension_numbers=('NWC', 'WIO', 'NWC'), feature_group_count=D_CONV) + conv_b
    new_hist = u_ext[:, -(CONV_WIDTH - 1):]
    c = jax.nn.silu(layernorm(c, conv_ln_g, conv_ln_b))

    heads = lambda t: t.reshape(B, T, N_RET_HEADS, HEAD_DIM).transpose(0, 2, 1, 3)
    pos = pos0 + jnp.arange(T)
    qh = rope(heads(q), pos)
    kh = rope(heads(k), pos) * (HEAD_DIM ** -0.5)
    o, R = retention(qh, kh, heads(v), R0)
    of = o.astype(jnp.float32)
    mu = jnp.mean(of, axis=-1, keepdims=True)
    var = jnp.mean(jnp.square(of - mu), axis=-1, keepdims=True)
    on = ((of - mu) * lax.rsqrt(var + EPS)).astype(h.dtype)
    r = on.transpose(0, 2, 1, 3).reshape(B, T, D_RET) * ret_gn_g
    r = jax.nn.silu(g) * r

    out = jnp.concatenate([c, r], axis=-1) @ w_out
    return out, new_hist, R


def layer(x, conv_hist, R0, pos0,
          ffn1_norm_pre, ffn1_w_gate, ffn1_w_up, ffn1_w_down, ffn1_norm_post,
          mix_norm_pre, w_in, conv_w, conv_b, conv_ln_g, conv_ln_b, ret_gn_g, w_out,
          mix_norm_post,
          ffn2_norm_pre, ffn2_w_gate, ffn2_w_up, ffn2_w_down, ffn2_norm_post):
    x = x + 0.5 * rmsnorm(swiglu(rmsnorm(x, ffn1_norm_pre), ffn1_w_gate, ffn1_w_up,
                                 ffn1_w_down), ffn1_norm_post)
    m, new_hist, R = mixer(rmsnorm(x, mix_norm_pre), conv_hist, R0, pos0, w_in, conv_w,
                           conv_b, conv_ln_g, conv_ln_b, ret_gn_g, w_out)
    x = x + rmsnorm(m, mix_norm_post)
    x = x + 0.5 * rmsnorm(swiglu(rmsnorm(x, ffn2_norm_pre), ffn2_w_gate, ffn2_w_up,
                                 ffn2_w_down), ffn2_norm_post)
    return x, new_hist, R


def setup_inputs(seed: int = 0) -> dict:
    key = jax.random.key(seed)
    ks = iter(jax.random.split(key, 32))
    nrm = lambda shape, s: jax.random.normal(next(ks), shape, jnp.float32) * s
    gain = lambda shape: 1.0 + nrm(shape, 0.02)
    L = DEPTH
    return {
        "x_prompt": nrm((BATCH, SEQ, D_MODEL), 1.0),
        "x_sample": nrm((DEC_BATCH, DEC_SEQ, D_MODEL), 1.0),
        "state_conv": nrm((L, DEC_BATCH, CONV_WIDTH - 1, D_CONV), 0.5),
        "state_ret": nrm((L, DEC_BATCH, N_RET_HEADS, HEAD_DIM, HEAD_DIM), 0.5),
        "ffn1_norm_pre": gain((L, D_MODEL)),
        "ffn1_w_gate": nrm((L, D_MODEL, D_FF), D_MODEL ** -0.5),
        "ffn1_w_up": nrm((L, D_MODEL, D_FF), D_MODEL ** -0.5),
        "ffn1_w_down": nrm((L, D_FF, D_MODEL), D_FF ** -0.5),
        "ffn1_norm_post": gain((L, D_MODEL)),
        "mix_norm_pre": gain((L, D_MODEL)),
        "w_in": nrm((L, D_MODEL, D_IN), D_MODEL ** -0.5),
        "conv_w": nrm((L, CONV_WIDTH, D_CONV), CONV_WIDTH ** -0.5),
        "conv_b": nrm((L, D_CONV), 0.02),
        "conv_ln_g": gain((L, D_CONV)),
        "conv_ln_b": nrm((L, D_CONV), 0.02),
        "ret_gn_g": gain((L, D_RET)),
        "w_out": nrm((L, D_MIX, D_MODEL), D_MIX ** -0.5),
        "mix_norm_post": gain((L, D_MODEL)),
        "ffn2_norm_pre": gain((L, D_MODEL)),
        "ffn2_w_gate": nrm((L, D_MODEL, D_FF), D_MODEL ** -0.5),
        "ffn2_w_up": nrm((L, D_MODEL, D_FF), D_MODEL ** -0.5),
        "ffn2_w_down": nrm((L, D_FF, D_MODEL), D_FF ** -0.5),
        "ffn2_norm_post": gain((L, D_MODEL)),
    }


def reference(x_prompt, x_sample, state_conv, state_ret,
              ffn1_norm_pre, ffn1_w_gate, ffn1_w_up, ffn1_w_down, ffn1_norm_post,
              mix_norm_pre, w_in, conv_w, conv_b, conv_ln_g, conv_ln_b, ret_gn_g, w_out,
              mix_norm_post,
              ffn2_norm_pre, ffn2_w_gate, ffn2_w_up, ffn2_w_down, ffn2_norm_post):
    yp, ys = x_prompt, x_sample
    Bp = x_prompt.shape[0]
    conv_p, ret_p, conv_s, ret_s = [], [], [], []
    for l in range(DEPTH):
        w = (ffn1_norm_pre[l], ffn1_w_gate[l], ffn1_w_up[l], ffn1_w_down[l],
             ffn1_norm_post[l], mix_norm_pre[l], w_in[l], conv_w[l], conv_b[l],
             conv_ln_g[l], conv_ln_b[l], ret_gn_g[l], w_out[l], mix_norm_post[l],
             ffn2_norm_pre[l], ffn2_w_gate[l], ffn2_w_up[l], ffn2_w_down[l],
             ffn2_norm_post[l])
        hist0 = jnp.zeros((Bp, CONV_WIDTH - 1, D_CONV), yp.dtype)
        R0 = jnp.zeros((Bp, N_RET_HEADS, HEAD_DIM, HEAD_DIM), yp.dtype)
        yp, hp, rp = layer(yp, hist0, R0, 0, *w)
        ys, hs, rs = layer(ys, state_conv[l], state_ret[l], PAST_LEN, *w)
        conv_p.append(hp); ret_p.append(rp); conv_s.append(hs); ret_s.append(rs)
    new_conv_prompt = jnp.stack(conv_p)
    new_ret_prompt = jnp.stack(ret_p)
    new_conv_sample = jnp.stack(conv_s)
    new_ret_sample = jnp.stack(ret_s)
    return (yp, ys, new_conv_prompt, new_ret_prompt, new_conv_sample, new_ret_sample)
```

```cpp
#include <hip/hip_runtime.h>
#include <cstdio>
#include <cstdint>
namespace pg8 {
#define PG8_LAS __attribute__((address_space(3)))
typedef unsigned short bf16_t;
typedef short bf16x8 __attribute__((ext_vector_type(8)));
typedef float f32x4 __attribute__((ext_vector_type(4)));
typedef unsigned u32x4 __attribute__((ext_vector_type(4)));
constexpr int BM = 256, BK = 64, HALF = 128, HTB = HALF * BK * 2  , STAGE_BYTES = 8 * HTB, NXCD = 8, WGM = 8;

__host__ __device__ __forceinline__ int lds_byte(int r, int c) { const int st = (r >> 4) * 2 + (c >> 5), rr = r & 15, cc = c & 31, ob = rr * 64 + cc * 2; return st * 1024 + (ob ^ (((ob >> 9) & 1) << 5)); }
__host__ __device__ __forceinline__ void stage_rc(int b, int& R, int& C) { const int st = b / 1024, sb = b % 1024, swz = sb ^ (((sb >> 9) & 1) << 5); R = (st >> 1) * 16 + swz / 64; C = (st & 1) * 32 + (swz % 64) / 2; }
__host__ __device__ __forceinline__ int perm32(int rho) { const int n = rho >> 4, i = rho & 15; return 8 * (i >> 2) + 4 * n + (i & 3); }

struct Unit { int pm, pn; };
struct Gemm { const bf16_t* A; const bf16_t* Bt; int M, N, K; };

struct StaticOrder {
    int nM, nN, nwg, G, c;
    __host__ __device__ void init(int M, int N, int G_, int c_) { nM = M / BM; nN = N / BM; nwg = nM * nN; G = G_; c = c_; }
    __host__ __device__ bool next(int i, Unit& u) const {
        const long L = (long)i * G + c; if (L >= nwg) return false;
        int wgid = (int)L; { const int q = nwg / NXCD, r = nwg % NXCD, xcd = wgid % NXCD, off = wgid / NXCD; wgid = (xcd < r ? xcd * (q + 1) : r * (q + 1) + (xcd - r) * q) + off; }
        const int nig = WGM * nN, gid = wgid / nig, fm = gid * WGM, gsz = (nM - fm) < WGM ? (nM - fm) : WGM;
        u.pm = fm + ((wgid % nig) % gsz); u.pn = (wgid % nig) / gsz; return true;
    }
    __device__ __forceinline__ void a_ready(const Unit&) const {}
    __device__ __forceinline__ void done(const Unit&) const {}
};

__device__ __forceinline__ unsigned cvt_pk_bf16(float lo, float hi) { unsigned r; asm volatile("v_cvt_pk_bf16_f32 %0, %1, %2" : "=v"(r) : "v"(lo), "v"(hi)); return r; }
__device__ __forceinline__ float fast_sigmoid(float x) { return __builtin_amdgcn_rcpf(1.0f + __builtin_amdgcn_exp2f(x * -1.44269504089f)); }
__device__ __forceinline__ float fast_silu(float x) { return x * fast_sigmoid(x); }

struct EpiF32 {
    static constexpr bool PERM = false, AFTER_DRAIN = false;
    float* C; int ldc;
    __device__ __forceinline__ void operator()(const f32x4 (&acc)[2][2][4][2], const Unit& u, int wr, int wc, int fr, int fq) const {
        const int row0 = u.pm * BM + wr * 64 + fr, col0 = u.pn * BM + wc * 32 + 4 * fq;
#pragma unroll
        for (int ai = 0; ai < 2; ++ai)
#pragma unroll
            for (int m = 0; m < 4; ++m) { float* rowp = C + (size_t)(row0 + ai * HALF + m * 16) * ldc + col0;
#pragma unroll
                for (int bj = 0; bj < 2; ++bj)
#pragma unroll
                    for (int n = 0; n < 2; ++n) *(f32x4*)(rowp + bj * HALF + n * 16) = acc[ai][bj][m][n]; }
    }
};
struct EpiBf16 {
    static constexpr bool PERM = true, AFTER_DRAIN = false;
    bf16_t* O; int ldc;
    __device__ __forceinline__ void operator()(const f32x4 (&acc)[2][2][4][2], const Unit& u, int wr, int wc, int fr, int fq) const {
        const int row0 = u.pm * BM + wr * 64 + fr, col0 = u.pn * BM + wc * 32 + 8 * fq;
#pragma unroll
        for (int ai = 0; ai < 2; ++ai)
#pragma unroll
            for (int m = 0; m < 4; ++m) { bf16_t* rowp = O + (size_t)(row0 + ai * HALF + m * 16) * ldc + col0;
#pragma unroll
                for (int bj = 0; bj < 2; ++bj) { const f32x4 v0 = acc[ai][bj][m][0], v1 = acc[ai][bj][m][1];
                    u32x4 w; w.x = cvt_pk_bf16(v0[0], v0[1]); w.y = cvt_pk_bf16(v0[2], v0[3]); w.z = cvt_pk_bf16(v1[0], v1[1]); w.w = cvt_pk_bf16(v1[2], v1[3]);
                    *(u32x4*)(rowp + bj * HALF) = w; } }
    }
};
struct EpiSwiglu {
    static constexpr bool PERM = true, AFTER_DRAIN = false;
    bf16_t* O; int ldc;
    __device__ __forceinline__ void operator()(const f32x4 (&acc)[2][2][4][2], const Unit& u, int wr, int wc, int fr, int fq) const {
        const int row0 = u.pm * BM + wr * 64 + fr, col0 = u.pn * HALF + wc * 32 + 8 * fq;
#pragma unroll
        for (int ai = 0; ai < 2; ++ai)
#pragma unroll
            for (int m = 0; m < 4; ++m) { bf16_t* rowp = O + (size_t)(row0 + ai * HALF + m * 16) * ldc + col0;
                const f32x4 g0 = acc[ai][0][m][0], g1 = acc[ai][0][m][1], u0 = acc[ai][1][m][0], u1 = acc[ai][1][m][1];
                u32x4 w; w.x = cvt_pk_bf16(fast_silu(g0[0]) * u0[0], fast_silu(g0[1]) * u0[1]); w.y = cvt_pk_bf16(fast_silu(g0[2]) * u0[2], fast_silu(g0[3]) * u0[3]);
                w.z = cvt_pk_bf16(fast_silu(g1[0]) * u1[0], fast_silu(g1[1]) * u1[1]); w.w = cvt_pk_bf16(fast_silu(g1[2]) * u1[2], fast_silu(g1[3]) * u1[3]);
                *(u32x4*)rowp = w; }
    }
};

template <class Epi, class Sched, bool ALIGN_EPI = false, bool SP2 = false>
__device__ __forceinline__ void gemm_phase(PG8_LAS unsigned char* lds, const Gemm g, const Sched& S, const Epi& E) {
    int tid_ = threadIdx.x; asm volatile("" : "+v"(tid_)); const int tid = tid_, wid = __builtin_amdgcn_readfirstlane(tid >> 6), lane = tid & 63, wr = wid >> 2, wc = wid & 3, fr = lane & 15, fq = lane >> 4;
    const int K = g.K, nt = K / BK;
    unsigned voffA[2], voffB[2];
#pragma unroll
    for (int i = 0; i < 2; ++i) { int R, C; stage_rc(tid * 16 + i * 8192, R, C); const int Rb = Epi::PERM ? ((R & ~31) + perm32(R & 31)) : R;
        voffA[i] = (unsigned)(R * K + C) * 2u; voffB[i] = (unsigned)(Rb * K + C) * 2u; }
    const size_t kstep = (size_t)(BK * 2);
    const size_t hstep = (size_t)HALF * K * 2;
    const size_t tstep = 2 * hstep;
    const unsigned ldsw = (unsigned)wid * 1024u;
    const int aoff = lds_byte(wr * 64 + fr, fq * 8), boff = lds_byte(wc * 32 + fr, fq * 8);
#define PG8_SA(b, h) (((b) * 2 + (h)) * HTB)
#define PG8_SB(b, h) ((4 + (b) * 2 + (h)) * HTB)
#define PG8_STAGE(bufoff, gbase, voff) do { _Pragma("unroll") for (int _i = 0; _i < 2; ++_i) \
        __builtin_amdgcn_global_load_lds((const unsigned*)((const char*)(gbase) + (voff)[_i]), (PG8_LAS unsigned*)(lds + (bufoff) + ldsw + _i * 8192), 16, 0, 0); } while (0)
#define PG8_LDA(dst, b, h) do { _Pragma("unroll") for (int m = 0; m < 4; ++m) _Pragma("unroll") for (int k = 0; k < 2; ++k) dst[m][k] = *(const PG8_LAS bf16x8*)(lds + PG8_SA(b, h) + aoff + m * 2048 + k * 1024); } while (0)
#define PG8_LDB(dst, b, h) do { _Pragma("unroll") for (int n = 0; n < 2; ++n) _Pragma("unroll") for (int k = 0; k < 2; ++k) dst[n][k] = *(const PG8_LAS bf16x8*)(lds + PG8_SB(b, h) + boff + n * 2048 + k * 1024); } while (0)
#define PG8_MMA(ai, bj, At, Bt) do { __builtin_amdgcn_s_setprio(1); _Pragma("unroll") for (int m = 0; m < 4; ++m) _Pragma("unroll") for (int n = 0; n < 2; ++n) _Pragma("unroll") for (int k = 0; k < 2; ++k) \
        acc[ai][bj][m][n] = __builtin_amdgcn_mfma_f32_16x16x32_bf16(Bt[n][k], At[m][k], acc[ai][bj][m][n], 0, 0, 0); __builtin_amdgcn_s_setprio(0); } while (0)
#define PG8_WAIT_V(n) asm volatile("s_waitcnt vmcnt(" #n ")" ::: "memory")
#define PG8_WAIT_L(n) asm volatile("s_waitcnt lgkmcnt(" #n ")" ::: "memory")
#define PG8_BAR __builtin_amdgcn_s_barrier()
#define PG8_SCHED __builtin_amdgcn_sched_barrier(0)
    Unit cur, nxt; int ui = 0;
    if (!S.next(0, cur)) return;
    f32x4 acc[2][2][4][2];
#pragma unroll
    for (int a = 0; a < 2; ++a)
#pragma unroll
        for (int b = 0; b < 2; ++b)
#pragma unroll
            for (int m = 0; m < 4; ++m)
#pragma unroll
                for (int n = 0; n < 2; ++n) acc[a][b][m][n] = (f32x4){0.f, 0.f, 0.f, 0.f};
    bf16x8 At[4][2], B0[2][2], B1[2][2];
    const char* cA = (const char*)g.A + (size_t)cur.pm * tstep; const char* cB = (const char*)g.Bt + (size_t)cur.pn * tstep;
    S.a_ready(cur);
    if constexpr (SP2) {
        PG8_STAGE(PG8_SB(0, 0), cB, voffB); PG8_STAGE(PG8_SB(0, 1), cB + hstep, voffB); PG8_STAGE(PG8_SA(0, 0), cA, voffA); PG8_STAGE(PG8_SA(0, 1), cA + hstep, voffA);
        if (wr == 1) PG8_BAR;
        PG8_WAIT_V(2); PG8_BAR;
        PG8_STAGE(PG8_SB(1, 0), cB + kstep, voffB); PG8_STAGE(PG8_SA(1, 0), cA + kstep, voffA); PG8_STAGE(PG8_SB(1, 1), cB + hstep + kstep, voffB);
        PG8_WAIT_V(6); PG8_BAR;
    } else {
        PG8_STAGE(PG8_SB(0, 0), cB, voffB); PG8_STAGE(PG8_SA(0, 0), cA, voffA); PG8_STAGE(PG8_SB(0, 1), cB + hstep, voffB); PG8_STAGE(PG8_SA(0, 1), cA + hstep, voffA);
        if (wr == 1) PG8_BAR;
        PG8_WAIT_V(4); PG8_BAR;
        PG8_STAGE(PG8_SB(1, 0), cB + kstep, voffB); PG8_STAGE(PG8_SA(1, 0), cA + kstep, voffA); PG8_STAGE(PG8_SB(1, 1), cB + hstep + kstep, voffB);
        PG8_WAIT_V(6); PG8_BAR;
    }
    for (;;) {
        const bool has_next = S.next(ui + 1, nxt);
        const char* nA = has_next ? (const char*)g.A + (size_t)nxt.pm * tstep : cA; const char* nB = has_next ? (const char*)g.Bt + (size_t)nxt.pn * tstep : cB;
        for (int t = 0; t < nt; t += 2) {
            const bool last = (t == nt - 2);
            const char* a1 = cA + (size_t)(t + 1) * kstep;
            const char* a2 = last ? nA : cA + (size_t)(t + 2) * kstep; const char* b2 = last ? nB : cB + (size_t)(t + 2) * kstep;
            const char* a3 = a2 + kstep; const char* b3 = b2 + kstep;
            if (last && has_next) S.a_ready(nxt);
            if constexpr (SP2) {
            PG8_LDB(B0, 0, 0); PG8_LDB(B1, 0, 1); PG8_SCHED; PG8_LDA(At, 0, 0); PG8_STAGE(PG8_SA(1, 1), a1 + hstep, voffA);
            PG8_WAIT_V(8); PG8_WAIT_L(0); PG8_BAR; PG8_MMA(0, 0, At, B0); PG8_MMA(0, 1, At, B1); PG8_BAR; PG8_SCHED;
            PG8_LDA(At, 0, 1); PG8_STAGE(PG8_SB(0, 0), b2, voffB); PG8_STAGE(PG8_SB(0, 1), b2 + hstep, voffB); PG8_STAGE(PG8_SA(0, 0), a2, voffA);
            PG8_WAIT_V(8); PG8_WAIT_L(0); PG8_BAR; PG8_MMA(1, 0, At, B0); PG8_MMA(1, 1, At, B1); PG8_BAR; PG8_SCHED;
            PG8_LDB(B0, 1, 0); PG8_LDB(B1, 1, 1); PG8_SCHED; PG8_LDA(At, 1, 0); PG8_STAGE(PG8_SA(0, 1), a2 + hstep, voffA);
            PG8_WAIT_V(8); PG8_WAIT_L(0); PG8_BAR; PG8_MMA(0, 0, At, B0); PG8_MMA(0, 1, At, B1); PG8_BAR; PG8_SCHED;
            PG8_LDA(At, 1, 1); PG8_STAGE(PG8_SB(1, 0), b3, voffB); PG8_STAGE(PG8_SB(1, 1), b3 + hstep, voffB); PG8_STAGE(PG8_SA(1, 0), a3, voffA);
            PG8_WAIT_V(8); PG8_WAIT_L(0); PG8_BAR; PG8_MMA(1, 0, At, B0); PG8_MMA(1, 1, At, B1); PG8_BAR; PG8_SCHED;
            } else {
            PG8_LDB(B0, 0, 0); PG8_SCHED; PG8_LDA(At, 0, 0); PG8_STAGE(PG8_SA(1, 1), a1 + hstep, voffA);
            PG8_WAIT_L(8); PG8_BAR; PG8_WAIT_L(0); PG8_MMA(0, 0, At, B0); PG8_BAR; PG8_SCHED;
            PG8_LDB(B1, 0, 1); PG8_STAGE(PG8_SB(0, 0), b2, voffB);
            PG8_BAR; PG8_WAIT_L(0); PG8_MMA(0, 1, At, B1); PG8_BAR;
            PG8_LDA(At, 0, 1); PG8_STAGE(PG8_SA(0, 0), a2, voffA);
            PG8_BAR; PG8_WAIT_L(0); PG8_MMA(1, 0, At, B0); PG8_BAR; PG8_SCHED;
            PG8_STAGE(PG8_SB(0, 1), b2 + hstep, voffB);
            PG8_WAIT_V(6); PG8_BAR; PG8_MMA(1, 1, At, B1); PG8_BAR;
            PG8_LDB(B0, 1, 0); PG8_SCHED; PG8_LDA(At, 1, 0); PG8_STAGE(PG8_SA(0, 1), a2 + hstep, voffA);
            PG8_WAIT_L(8); PG8_BAR; PG8_WAIT_L(0); PG8_MMA(0, 0, At, B0); PG8_BAR; PG8_SCHED;
            PG8_LDB(B1, 1, 1); PG8_STAGE(PG8_SB(1, 0), b3, voffB);
            PG8_BAR; PG8_WAIT_L(0); PG8_MMA(0, 1, At, B1); PG8_BAR;
            PG8_LDA(At, 1, 1); PG8_STAGE(PG8_SA(1, 0), a3, voffA);
            PG8_BAR; PG8_WAIT_L(0); PG8_MMA(1, 0, At, B0); PG8_BAR; PG8_SCHED;
            PG8_STAGE(PG8_SB(1, 1), b3 + hstep, voffB);
            PG8_WAIT_V(6); PG8_BAR; PG8_MMA(1, 1, At, B1); PG8_BAR;
            }
        }
        if constexpr (ALIGN_EPI) { if (wr == 0) PG8_BAR; }
        if constexpr (!Epi::AFTER_DRAIN) { E(acc, cur, wr, wc, fr, fq); S.done(cur); }
        if (!has_next) break;
#pragma unroll
        for (int a = 0; a < 2; ++a)
#pragma unroll
            for (int b = 0; b < 2; ++b)
#pragma unroll
                for (int m = 0; m < 4; ++m)
#pragma unroll
                    for (int n = 0; n < 2; ++n) acc[a][b][m][n] = (f32x4){0.f, 0.f, 0.f, 0.f};
        cur = nxt; cA = nA; cB = nB; ++ui;
        if constexpr (ALIGN_EPI) { if (wr == 1) PG8_BAR; }
    }
    PG8_WAIT_V(0);
    if constexpr (!ALIGN_EPI) { if (wr == 0) PG8_BAR; }
    PG8_BAR;
    if constexpr (Epi::AFTER_DRAIN) { E.fused(acc, cur, wr, wc, fr, fq, lds, wid, lane); S.done(cur); }
#undef PG8_SA
#undef PG8_SB
#undef PG8_STAGE
#undef PG8_LDA
#undef PG8_LDB
#undef PG8_MMA
#undef PG8_WAIT_V
#undef PG8_WAIT_L
#undef PG8_BAR
#undef PG8_SCHED
}
}

#ifndef PG8_SP2
#define PG8_SP2 true
#endif
#ifndef PG8_ALIGN
#define PG8_ALIGN true
#endif

constexpr int NWAVES = 8;
#ifndef MK_N_LAUNCHES
#define MK_N_LAUNCHES 1
#endif
constexpr int PER_PHASE = 12;
constexpr int N_LAUNCHES = MK_N_LAUNCHES;

constexpr int MP = 16384, MS = 256, M = MP + MS;
constexpr int D = 1024, FF = 2816, DIN = 3072, DC = 512, NH = 4, HD = 128, TP = 8192, TS = 32, CWID = 31, PAST = 4096;
constexpr float EPS = 1e-6f;
constexpr size_t O_Y = 0, O_CP = (size_t)M * D, O_RP = O_CP + 2 * 30 * DC, O_CS = O_RP + 2 * NH * HD * HD, O_RS = O_CS + 8 * 30 * DC, O_END = O_RS + 8 * NH * HD * HD;
static_assert(O_END == 17848320, "output size");

constexpr size_t MiB = 1u << 20;
constexpr size_t WS_CTL = 0, CTL_ZERO_BYTES = 1 * MiB;
constexpr size_t WS_WGU1 = 1 * MiB, WS_WD1 = 12 * MiB, WS_WIN = WS_WD1 + 5632 * 1024, WS_WOUT = WS_WIN + 6 * MiB, WS_WGU2 = WS_WOUT + 2 * MiB, WS_WD2 = WS_WGU2 + 11 * MiB;
constexpr size_t WS_H = 42 * MiB;
constexpr size_t WS_ACT = 75 * MiB;
constexpr size_t WS_F = 173 * MiB;
constexpr size_t WS_END = 238 * MiB;
static_assert(WS_WD2 + (size_t)D * FF * 2 <= WS_H && WS_H + (size_t)M * D * 2 <= WS_ACT && WS_ACT + (size_t)M * DIN * 2 <= WS_F && WS_F + (size_t)M * D * 4 <= WS_END, "d_ws map");
constexpr int CW_BAR = 4096;

constexpr int RING_OFF = 0, RING_BYTES = 131072;
constexpr int LDSCTL_OFF = RING_BYTES, MISC_OFF = LDSCTL_OFF + 320;
constexpr int LDS_BYTES = 147456;
static_assert(MISC_OFF + 128 <= LDS_BYTES, "LDS map");
#define GAS __attribute__((address_space(1)))
#define LAS __attribute__((address_space(3)))
typedef unsigned short bf16;
typedef unsigned v4u __attribute__((ext_vector_type(4)));
typedef float f32x4 __attribute__((ext_vector_type(4)));
typedef short bf16x8 __attribute__((ext_vector_type(8)));
typedef GAS unsigned gu32;
typedef GAS unsigned long long gu64;
#define RLX_AGENT __ATOMIC_RELAXED, __HIP_MEMORY_SCOPE_AGENT
#define LDS_WAIT() asm volatile("s_waitcnt lgkmcnt(0)" ::: "memory")
#define VM_WAIT() asm volatile("s_waitcnt vmcnt(0)" ::: "memory")
__device__ __forceinline__ unsigned long long rt() { return __builtin_amdgcn_s_memrealtime(); }
__device__ __forceinline__ unsigned f2bf(float f) { unsigned u = __builtin_bit_cast(unsigned, f); return (u + 0x7fffu + ((u >> 16) & 1u)) >> 16; }
__device__ __forceinline__ unsigned pk2(float lo, float hi) { return f2bf(lo) | (f2bf(hi) << 16); }

#define XB_TMO      128
#define XB_XCNT(j)  (256  + 64 * (j))
#define XB_XSUB(j)  (1280 + 64 * (j))
#define XB_XGEN(j)  (2304 + 64 * (j))
#define XB_TOP      3328
#define XB_TOPGEN   3392
#define XCD_BAR_WORDS 3456
#define XB_SPIN_CAP (1u << 18)

__device__ __forceinline__ unsigned xb_ld(unsigned* p)              { return __hip_atomic_load(p, __ATOMIC_RELAXED, __HIP_MEMORY_SCOPE_AGENT); }
__device__ __forceinline__ unsigned xb_add(unsigned* p, unsigned v) { return __hip_atomic_fetch_add(p, v, __ATOMIC_RELAXED, __HIP_MEMORY_SCOPE_AGENT); }
__device__ __forceinline__ unsigned xb_xcc_id() { return (unsigned)__builtin_amdgcn_s_getreg((3 << 11) | 20) & 0xFu; }
#define XB_SPIN(cond, bar) do { unsigned _sp = 0; while (cond) { __builtin_amdgcn_s_sleep(1); \
    if ((++_sp & 255u) == 0u) { if (xb_ld(&(bar)[XB_TMO])) break; if (_sp > XB_SPIN_CAP) { atomicAdd(&(bar)[XB_TMO], 1u); break; } } } } while (0)

struct XcdBarrier {
    unsigned* bar; unsigned x;
    volatile LAS unsigned* st;
};

__device__ __forceinline__ XcdBarrier xcd_barrier_post(unsigned* bar, volatile LAS unsigned* st) {
    XcdBarrier b; b.bar = bar; b.x = xb_xcc_id(); b.st = st;
    if (threadIdx.x == 0) (void)xb_add(&bar[XB_XCNT(b.x)], 1u);
    return b;
}
__device__ __forceinline__ void xcd_barrier_complete(unsigned* bar, unsigned x, unsigned& nloc, unsigned& nx) {
    const unsigned G = gridDim.x * gridDim.y * gridDim.z;
    unsigned sum, cnt, mine, sp = 0u;
    for (;;) {
        sum = 0u; cnt = 0u; mine = 0u;
#pragma unroll
        for (unsigned j = 0; j < 16; ++j) { const unsigned c = xb_ld(&bar[XB_XCNT(j)]); sum += c; cnt += (c > 0u) ? 1u : 0u; mine = (j == x) ? c : mine; }
        if (sum == G) break;
        __builtin_amdgcn_s_sleep(1);
        if ((++sp & 255u) == 0u) { if (xb_ld(&bar[XB_TMO])) break; if (sp > XB_SPIN_CAP) { atomicAdd(&bar[XB_TMO], 1u); break; } }
    }
    nloc = mine > 0u ? mine : 1u; nx = cnt > 0u ? cnt : 1u;
}

__device__ __forceinline__ void xcd_barrier(const XcdBarrier& b) {
    asm volatile("s_waitcnt vmcnt(0)" ::: "memory");
    __syncthreads();
    if (threadIdx.x == 0) {
        unsigned* bar = b.bar;
        __builtin_amdgcn_s_waitcnt(0);
        unsigned nloc = b.st[0], nx = b.st[1];
        if (nloc == 0u) { xcd_barrier_complete(bar, b.x, nloc, nx); b.st[0] = nloc; b.st[1] = nx; }
        const unsigned old = xb_add(&bar[XB_XSUB(b.x)], 1u);
        const unsigned gen = old / nloc;
        if (old + 1u == (gen + 1u) * nloc) {
            __builtin_amdgcn_fence(__ATOMIC_RELEASE, "agent");
            asm volatile("s_waitcnt vmcnt(0)" ::: "memory");
            const unsigned og = xb_add(&bar[XB_TOP], 1u);
            const unsigned tg = og / nx;
            if (og + 1u == (tg + 1u) * nx) xb_add(&bar[XB_TOPGEN], 1u);
            else XB_SPIN(xb_ld(&bar[XB_TOPGEN]) == tg, bar);
            __builtin_amdgcn_fence(__ATOMIC_ACQUIRE, "agent");
            xb_add(&bar[XB_XGEN(b.x)], 1u);
            asm volatile("s_waitcnt vmcnt(0)" ::: "memory");
        } else {
            XB_SPIN(xb_ld(&bar[XB_XGEN(b.x)]) == gen, bar);
            __builtin_amdgcn_fence(__ATOMIC_ACQUIRE, "agent");
            asm volatile("s_waitcnt vmcnt(0)" ::: "memory");
        }
    }
    __syncthreads();
}


typedef float f32x2 __attribute__((ext_vector_type(2)));
typedef unsigned u32x2 __attribute__((ext_vector_type(2)));
__device__ __forceinline__ float wave_sum(float v) {
#pragma unroll
    for (int o = 1; o < 64; o <<= 1) v += __shfl_xor(v, o);
    return v;
}
__device__ __forceinline__ float bf_lo(unsigned w) { return __builtin_bit_cast(float, w << 16); }
__device__ __forceinline__ float bf_hi(unsigned w) { return __builtin_bit_cast(float, w & 0xffff0000u); }
__device__ __forceinline__ float bf1(bf16 b) { return __builtin_bit_cast(float, (unsigned)b << 16); }
__device__ __forceinline__ float sigmoidf_(float x) { return 1.0f / (1.0f + __expf(-x)); }

__device__ __forceinline__ void p0_transpose_item(const float* W, int K, int N, bf16* WT, int mode, LAS float* scr, int item, int lane) {
    const int nblk = N / 32, kb = item / nblk, nb = item % nblk, k0 = 64 * kb, n0 = 32 * nb;
#pragma unroll 8
    for (int i = 0; i < 32; ++i) { const int kk = 2 * i + (lane >> 5); scr[kk * 33 + (lane & 31)] = W[(size_t)(k0 + kk) * N + n0 + (lane & 31)]; }
    LDS_WAIT(); asm volatile("" ::: "memory");
    const int r0 = (mode == 0) ? n0 : ((n0 >> 7) * 256 + (n0 & 127) + (mode == 2 ? 128 : 0));
    const int c = lane & 7;
#pragma unroll
    for (int j = 0; j < 4; ++j) { const int n = (lane >> 3) + 8 * j; const LAS float* s = scr + (8 * c) * 33 + n;
        v4u o; o.x = pk2(s[0 * 33], s[1 * 33]); o.y = pk2(s[2 * 33], s[3 * 33]); o.z = pk2(s[4 * 33], s[5 * 33]); o.w = pk2(s[6 * 33], s[7 * 33]);
        *(GAS v4u*)(WT + (size_t)(r0 + n) * K + k0 + 8 * c) = o; }
    LDS_WAIT(); asm volatile("" ::: "memory");
}
__device__ __forceinline__ void rms_row_to_bf16(const float* xrow, const float* gain, bf16* orow, int lane) {
    const GAS f32x4* xr = (const GAS f32x4*)xrow + lane; const GAS f32x4* gr = (const GAS f32x4*)gain + lane;
    f32x4 v[4]; float s = 0.f;
#pragma unroll
    for (int j = 0; j < 4; ++j) { v[j] = xr[64 * j]; s += (v[j].x * v[j].x + v[j].y * v[j].y) + (v[j].z * v[j].z + v[j].w * v[j].w); }
    const float rstd = 1.f / sqrtf(wave_sum(s) * (1.f / D) + EPS);
    GAS unsigned long long* o8 = (GAS unsigned long long*)orow + lane;
#pragma unroll
    for (int j = 0; j < 4; ++j) { const f32x4 g = gr[64 * j];
        o8[64 * j] = (unsigned long long)pk2(v[j].x * rstd * g.x, v[j].y * rstd * g.y) | ((unsigned long long)pk2(v[j].z * rstd * g.z, v[j].w * rstd * g.w) << 32); }
}

__device__ __forceinline__ void norm_row(const float* frow, const float* xrow, float scale, const float* gpost, float* yrow, const float* gnext, bf16* hrow, int lane) {
    const GAS f32x4* fr_ = (const GAS f32x4*)frow + lane; const GAS f32x4* xr = (const GAS f32x4*)xrow + lane; const GAS f32x4* gp = (const GAS f32x4*)gpost + lane;
    f32x4 f[4], x[4]; float s = 0.f;
#pragma unroll
    for (int j = 0; j < 4; ++j) { f[j] = fr_[64 * j]; x[j] = xr[64 * j]; s += (f[j].x * f[j].x + f[j].y * f[j].y) + (f[j].z * f[j].z + f[j].w * f[j].w); }
    const float rf = scale / sqrtf(wave_sum(s) * (1.f / D) + EPS);
    float s2 = 0.f;
    GAS f32x4* yo = (GAS f32x4*)yrow + lane;
#pragma unroll
    for (int j = 0; j < 4; ++j) { const f32x4 g = gp[64 * j]; x[j] = x[j] + f[j] * g * rf; yo[64 * j] = x[j];
        s2 += (x[j].x * x[j].x + x[j].y * x[j].y) + (x[j].z * x[j].z + x[j].w * x[j].w); }
    if (gnext) {
        const float rstd = 1.f / sqrtf(wave_sum(s2) * (1.f / D) + EPS);
        const GAS f32x4* gn = (const GAS f32x4*)gnext + lane; GAS unsigned long long* o8 = (GAS unsigned long long*)hrow + lane;
#pragma unroll
        for (int j = 0; j < 4; ++j) { const f32x4 g = gn[64 * j];
            o8[64 * j] = (unsigned long long)pk2(x[j].x * rstd * g.x, x[j].y * rstd * g.y) | ((unsigned long long)pk2(x[j].z * rstd * g.z, x[j].w * rstd * g.w) << 32); }
    }
}

constexpr int CS_LD = 516;
__device__ __forceinline__ void conv_unit(LAS unsigned char* lds, int cu, const bf16* P, const float* state_conv, const float* conv_w, const float* conv_b,
                                          const float* ln_g, const float* ln_b, bf16* MIX, float* out, int tid, int lane, int wave) {
    const bool smp = cu >= 512; const int b = smp ? cu - 512 : cu >> 8, T0 = smp ? 0 : (cu & 255) * 32;
    const size_t rb = smp ? (size_t)MP + b * TS : (size_t)b * TP;
    const bool tail = smp || (cu & 255) == 255;
    float* nh = out + (smp ? O_CS : O_CP) + (size_t)b * 30 * DC;
    const int ch = tid;
    float w[CWID], acc[32];
#pragma unroll
    for (int j = 0; j < CWID; ++j) w[j] = conv_w[j * DC + ch];
    const float bias = conv_b[ch];
#pragma unroll
    for (int t = 0; t < 32; ++t) acc[t] = bias;
#pragma unroll
    for (int ee = 0; ee < 62; ++ee) {
        const int ts = T0 + ee - 30;
        float v;
        if (ts >= 0) { const bf16* pr = P + (rb + ts) * DIN; const float a = bf1(((const GAS bf16*)pr)[ch]), g = bf1(((const GAS bf16*)pr)[DC + ch]); v = a * sigmoidf_(g); }
        else v = smp ? state_conv[((size_t)b * 30 + (30 + ts)) * DC + ch] : 0.f;
        if (tail && ee >= 32) nh[(size_t)(ee - 32) * DC + ch] = v;
#pragma unroll
        for (int t = 0; t < 32; ++t) { const int j = ee - t; if (j >= 0 && j < CWID) acc[t] += w[j] * v; }
    }
    LAS float* cs = (LAS float*)lds;
#pragma unroll
    for (int t = 0; t < 32; ++t) cs[t * CS_LD + ch] = acc[t];
    __syncthreads();
    const f32x4 g0 = ((const GAS f32x4*)ln_g)[2 * lane], g1 = ((const GAS f32x4*)ln_g)[2 * lane + 1], b0 = ((const GAS f32x4*)ln_b)[2 * lane], b1 = ((const GAS f32x4*)ln_b)[2 * lane + 1];
#pragma unroll
    for (int tt = 0; tt < 4; ++tt) { const int t = wave * 4 + tt;
        f32x4 x0 = *(const LAS f32x4*)(cs + t * CS_LD + 8 * lane), x1 = *(const LAS f32x4*)(cs + t * CS_LD + 8 * lane + 4);
        const float mean = wave_sum((x0.x + x0.y) + (x0.z + x0.w) + (x1.x + x1.y) + (x1.z + x1.w)) * (1.f / DC);
        x0 = x0 - mean; x1 = x1 - mean;
        const float var = wave_sum((x0.x * x0.x + x0.y * x0.y) + (x0.z * x0.z + x0.w * x0.w) + (x1.x * x1.x + x1.y * x1.y) + (x1.z * x1.z + x1.w * x1.w)) * (1.f / DC);
        const float rstd = 1.f / sqrtf(var + EPS);
        x0 = x0 * rstd * g0 + b0; x1 = x1 * rstd * g1 + b1;
        v4u o; o.x = pk2(x0.x * sigmoidf_(x0.x), x0.y * sigmoidf_(x0.y)); o.y = pk2(x0.z * sigmoidf_(x0.z), x0.w * sigmoidf_(x0.w));
        o.z = pk2(x1.x * sigmoidf_(x1.x), x1.y * sigmoidf_(x1.y)); o.w = pk2(x1.z * sigmoidf_(x1.z), x1.w * sigmoidf_(x1.w));
        *(GAS v4u*)(MIX + (rb + T0 + t) * D + 8 * lane) = o; }
    __syncthreads();
}

constexpr int R_QS = 0, R_KS = 17408, R_KZT = 34816, R_VT = 53248, R_RT = 71680, R_SS = 106496, R_OS = 0;
constexpr int QS_LD = 136, KT_LD = 72, RT_LD = 136, SS_LD = 72, OS_LD = 132;
static_assert(R_SS + 64 * SS_LD * 2 <= RING_BYTES && 64 * OS_LD * 4 <= R_KZT, "retention LDS map");
struct RetCtx { const bf16* P; size_t row0; int pos0, C, h; float lg; };

template <bool WITH_Q>
__device__ __forceinline__ void ret_stage(LAS unsigned char* lds, const RetCtx& c, int tid) {
    const int j = tid >> 3, cc = tid & 7; const bool valid = j < c.C;
    const GAS bf16* prow = (const GAS bf16*)(c.P + (c.row0 + (valid ? j : 0)) * DIN) + c.h * HD + 8 * cc;
    v4u k1 = *(const GAS v4u*)(prow + 1536), k2 = *(const GAS v4u*)(prow + 1536 + 64), v1 = *(const GAS v4u*)(prow + 2048), v2 = *(const GAS v4u*)(prow + 2048 + 64);
    v4u q1 = (v4u){0u, 0u, 0u, 0u}, q2 = q1;
    if (WITH_Q) { q1 = *(const GAS v4u*)(prow + 1024); q2 = *(const GAS v4u*)(prow + 1024 + 64); }
    if (!valid) { k1 = k2 = v1 = v2 = q1 = q2 = (v4u){0u, 0u, 0u, 0u}; }
    float cs[8], sn[8]; const float pos = (float)(c.pos0 + j);
#pragma unroll
    for (int i = 0; i < 8; ++i) { const float inv = exp2f((float)(8 * cc + i) * (-13.287712379549449f / 64.0f)); const float ang = pos * inv;
        const float n = rintf(ang * 0.15915494309189535f); float r = fmaf(-n, 6.2831854820251465f, ang); r = fmaf(-n, -1.7484555e-07f, r);
        const float rev = r * 0.15915494309189535f; cs[i] = __builtin_amdgcn_cosf(rev); sn[i] = __builtin_amdgcn_sinf(rev); }
    const float z = valid ? __expf(c.lg * (float)(c.C - 1 - j)) : 0.f;
    const float KS = 0.08838834764831845f;
    float a1[8], a2[8];
#pragma unroll
    for (int i = 0; i < 4; ++i) { a1[2 * i] = bf_lo(k1[i]); a1[2 * i + 1] = bf_hi(k1[i]); a2[2 * i] = bf_lo(k2[i]); a2[2 * i + 1] = bf_hi(k2[i]); }
    float r1[8], r2[8];
#pragma unroll
    for (int i = 0; i < 8; ++i) { r1[i] = (a1[i] * cs[i] - a2[i] * sn[i]) * KS; r2[i] = (a2[i] * cs[i] + a1[i] * sn[i]) * KS; }
    LAS bf16* KzT = (LAS bf16*)(lds + R_KZT); LAS bf16* VT = (LAS bf16*)(lds + R_VT);
#pragma unroll
    for (int i = 0; i < 8; ++i) { KzT[(8 * cc + i) * KT_LD + j] = (bf16)f2bf(r1[i] * z); KzT[(64 + 8 * cc + i) * KT_LD + j] = (bf16)f2bf(r2[i] * z); }
#pragma unroll
    for (int i = 0; i < 4; ++i) { VT[(8 * cc + 2 * i) * KT_LD + j] = (bf16)(v1[i] & 0xffffu); VT[(8 * cc + 2 * i + 1) * KT_LD + j] = (bf16)(v1[i] >> 16);
                                  VT[(64 + 8 * cc + 2 * i) * KT_LD + j] = (bf16)(v2[i] & 0xffffu); VT[(64 + 8 * cc + 2 * i + 1) * KT_LD + j] = (bf16)(v2[i] >> 16); }
    if (WITH_Q) {
        LAS bf16* Ks = (LAS bf16*)(lds + R_KS); LAS bf16* Qs = (LAS bf16*)(lds + R_QS);
        v4u o; o.x = pk2(r1[0], r1[1]); o.y = pk2(r1[2], r1[3]); o.z = pk2(r1[4], r1[5]); o.w = pk2(r1[6], r1[7]); *(LAS v4u*)(Ks + j * QS_LD + 8 * cc) = o;
        o.x = pk2(r2[0], r2[1]); o.y = pk2(r2[2], r2[3]); o.z = pk2(r2[4], r2[5]); o.w = pk2(r2[6], r2[7]); *(LAS v4u*)(Ks + j * QS_LD + 64 + 8 * cc) = o;
#pragma unroll
        for (int i = 0; i < 4; ++i) { a1[2 * i] = bf_lo(q1[i]); a1[2 * i + 1] = bf_hi(q1[i]); a2[2 * i] = bf_lo(q2[i]); a2[2 * i + 1] = bf_hi(q2[i]); }
#pragma unroll
        for (int i = 0; i < 8; ++i) { r1[i] = a1[i] * cs[i] - a2[i] * sn[i]; r2[i] = a2[i] * cs[i] + a1[i] * sn[i]; }
        o.x = pk2(r1[0], r1[1]); o.y = pk2(r1[2], r1[3]); o.z = pk2(r1[4], r1[5]); o.w = pk2(r1[6], r1[7]); *(LAS v4u*)(Qs + j * QS_LD + 8 * cc) = o;
        o.x = pk2(r2[0], r2[1]); o.y = pk2(r2[2], r2[3]); o.z = pk2(r2[4], r2[5]); o.w = pk2(r2[6], r2[7]); *(LAS v4u*)(Qs + j * QS_LD + 64 + 8 * cc) = o;
    }
}
#define MFMA16(a, b, c) __builtin_amdgcn_mfma_f32_16x16x32_bf16((a), (b), (c), 0, 0, 0)
__device__ __forceinline__ void ret_update(LAS unsigned char* lds, f32x4 (&racc)[8], float gch, int w, int fr, int fq) {
    const LAS bf16* KzT = (const LAS bf16*)(lds + R_KZT); const LAS bf16* VT = (const LAS bf16*)(lds + R_VT);
#pragma unroll
    for (int vb = 0; vb < 8; ++vb) racc[vb] = racc[vb] * gch;
#pragma unroll
    for (int ks = 0; ks < 2; ++ks) { const bf16x8 a = *(const LAS bf16x8*)(KzT + (16 * w + fr) * KT_LD + 32 * ks + 8 * fq);
#pragma unroll
        for (int vb = 0; vb < 8; ++vb) { const bf16x8 bb = *(const LAS bf16x8*)(VT + (16 * vb + fr) * KT_LD + 32 * ks + 8 * fq); racc[vb] = MFMA16(a, bb, racc[vb]); } }
}
__device__ __forceinline__ void ret_write_rt(LAS unsigned char* lds, const f32x4 (&racc)[8], int w, int fr, int fq) {
    LAS bf16* RT = (LAS bf16*)(lds + R_RT);
#pragma unroll
    for (int vb = 0; vb < 8; ++vb) { u32x2 o; o.x = pk2(racc[vb][0], racc[vb][1]); o.y = pk2(racc[vb][2], racc[vb][3]); *(LAS u32x2*)(RT + (16 * vb + fr) * RT_LD + 16 * w + 4 * fq) = o; }
}
__device__ __forceinline__ void ret_pass_a(LAS unsigned char* lds, const bf16* P, int unit, float* AGG, int tid, int lane, int wave) {
    const int b = unit >> 7, h = (unit >> 5) & 3, grp = unit & 31, fr = lane & 15, fq = lane >> 4;
    const float lg = log1pf(-exp2f(-5.0f - (float)h)), gch = __expf(lg * 64.f);
    f32x4 racc[8];
#pragma unroll
    for (int vb = 0; vb < 8; ++vb) racc[vb] = (f32x4){0.f, 0.f, 0.f, 0.f};
    for (int ci = 0; ci < 4; ++ci) {
        RetCtx c{P, (size_t)b * TP + (size_t)(grp * 4 + ci) * 64, (grp * 4 + ci) * 64, 64, h, lg};
        ret_stage<false>(lds, c, tid);
        __syncthreads();
        ret_update(lds, racc, gch, wave, fr, fq);
        __syncthreads();
    }
    float* o = AGG + (size_t)unit * (HD * HD);
#pragma unroll
    for (int vb = 0; vb < 8; ++vb)
#pragma unroll
        for (int r = 0; r < 4; ++r) ((GAS float*)o)[(16 * wave + 4 * fq + r) * HD + 16 * vb + fr] = racc[vb][r];
}
__device__ __forceinline__ void ret_pass_b(LAS unsigned char* lds, const bf16* P, int unit, bool smp, const float* AGG, const float* state_ret, const float* gn_g, bf16* MIX, float* out,
                                           int tid, int lane, int wave) {
    const int b = smp ? unit >> 2 : unit >> 7, h = smp ? unit & 3 : (unit >> 5) & 3, grp = smp ? 0 : unit & 31, fr = lane & 15, fq = lane >> 4, w = wave;
    const int C = smp ? TS : 64, nch = smp ? 1 : 4;
    const float lg = log1pf(-exp2f(-5.0f - (float)h)), gch = __expf(lg * (float)C);
    f32x4 racc[8];
    if (smp) { const GAS float* s = (const GAS float*)state_ret + (size_t)(b * NH + h) * (HD * HD);
#pragma unroll
        for (int vb = 0; vb < 8; ++vb)
#pragma unroll
            for (int r = 0; r < 4; ++r) racc[vb][r] = s[(16 * w + 4 * fq + r) * HD + 16 * vb + fr];
    } else {
        const float g4 = __expf(lg * 256.f);
#pragma unroll
        for (int vb = 0; vb < 8; ++vb) racc[vb] = (f32x4){0.f, 0.f, 0.f, 0.f};
        for (int gp = 0; gp < grp; ++gp) { const GAS float* s = (const GAS float*)AGG + (size_t)((unit & ~31) + gp) * (HD * HD);
#pragma unroll
            for (int vb = 0; vb < 8; ++vb)
#pragma unroll
                for (int r = 0; r < 4; ++r) racc[vb][r] = racc[vb][r] * g4 + s[(16 * w + 4 * fq + r) * HD + 16 * vb + fr]; }
    }
    ret_write_rt(lds, racc, w, fr, fq);
    const LAS bf16* Qs = (const LAS bf16*)(lds + R_QS); const LAS bf16* Ks = (const LAS bf16*)(lds + R_KS); const LAS bf16* VT = (const LAS bf16*)(lds + R_VT);
    const LAS bf16* RT = (const LAS bf16*)(lds + R_RT); LAS bf16* Ss = (LAS bf16*)(lds + R_SS); LAS float* Os = (LAS float*)(lds + R_OS);
    for (int ci = 0; ci < nch; ++ci) {
        const size_t row0 = smp ? (size_t)MP + b * TS : (size_t)b * TP + (size_t)(grp * 4 + ci) * 64;
        RetCtx c{P, row0, smp ? PAST : (grp * 4 + ci) * 64, C, h, lg};
        ret_stage<true>(lds, c, tid);
        __syncthreads();
        {
            const int ib = w >> 1, jb0 = 2 * (w & 1);
            f32x4 sacc[2] = {(f32x4){0.f, 0.f, 0.f, 0.f}, (f32x4){0.f, 0.f, 0.f, 0.f}};
#pragma unroll
            for (int ks = 0; ks < 4; ++ks) { const bf16x8 a = *(const LAS bf16x8*)(Qs + (16 * ib + fr) * QS_LD + 32 * ks + 8 * fq);
#pragma unroll
                for (int t = 0; t < 2; ++t) { const bf16x8 bb = *(const LAS bf16x8*)(Ks + (16 * (jb0 + t) + fr) * QS_LD + 32 * ks + 8 * fq); sacc[t] = MFMA16(a, bb, sacc[t]); } }
#pragma unroll
            for (int t = 0; t < 2; ++t) { const int j = 16 * (jb0 + t) + fr;
#pragma unroll
                for (int r = 0; r < 4; ++r) { const int i = 16 * ib + 4 * fq + r; const float v = (i >= j) ? sacc[t][r] * __expf(lg * (float)(i - j)) : 0.f; Ss[i * SS_LD + j] = (bf16)f2bf(v); } }
        }
        __syncthreads();
        f32x4 oacc[4];
#pragma unroll
        for (int ib = 0; ib < 4; ++ib) oacc[ib] = (f32x4){0.f, 0.f, 0.f, 0.f};
#pragma unroll
        for (int ks = 0; ks < 4; ++ks) { const bf16x8 bb = *(const LAS bf16x8*)(RT + (16 * w + fr) * RT_LD + 32 * ks + 8 * fq);
#pragma unroll
            for (int ib = 0; ib < 4; ++ib) { const bf16x8 a = *(const LAS bf16x8*)(Qs + (16 * ib + fr) * QS_LD + 32 * ks + 8 * fq); oacc[ib] = MFMA16(a, bb, oacc[ib]); } }
#pragma unroll
        for (int ib = 0; ib < 4; ++ib)
#pragma unroll
            for (int r = 0; r < 4; ++r) oacc[ib][r] *= __expf(lg * (float)(16 * ib + 4 * fq + r + 1));
#pragma unroll
        for (int ks = 0; ks < 2; ++ks) { const bf16x8 bb = *(const LAS bf16x8*)(VT + (16 * w + fr) * KT_LD + 32 * ks + 8 * fq);
#pragma unroll
            for (int ib = 0; ib < 4; ++ib) { const bf16x8 a = *(const LAS bf16x8*)(Ss + (16 * ib + fr) * SS_LD + 32 * ks + 8 * fq); oacc[ib] = MFMA16(a, bb, oacc[ib]); } }
        __syncthreads();
#pragma unroll
        for (int ib = 0; ib < 4; ++ib)
#pragma unroll
            for (int r = 0; r < 4; ++r) Os[(16 * ib + 4 * fq + r) * OS_LD + 16 * w + fr] = oacc[ib][r];
        ret_update(lds, racc, gch, w, fr, fq);
        ret_write_rt(lds, racc, w, fr, fq);
        __syncthreads();
        {
            const f32x2 gg = *(const GAS f32x2*)(gn_g + h * HD + 2 * lane);
#pragma unroll
            for (int tt = 0; tt < 8; ++tt) { const int i = 8 * w + tt;
                if (i < C) {
                    f32x2 x = *(const LAS f32x2*)(Os + i * OS_LD + 2 * lane);
                    const float mu = wave_sum(x.x + x.y) * (1.f / HD); x = x - mu;
                    const float var = wave_sum(x.x * x.x + x.y * x.y) * (1.f / HD), rstd = 1.f / sqrtf(var + EPS);
                    const unsigned gw = *(const GAS unsigned*)(P + (row0 + i) * DIN + 2560 + h * HD + 2 * lane);
                    const float g0 = bf_lo(gw), g1 = bf_hi(gw);
                    *(GAS unsigned*)(MIX + (row0 + i) * D + DC + h * HD + 2 * lane) = pk2(x.x * rstd * gg.x * (g0 * sigmoidf_(g0)), x.y * rstd * gg.y * (g1 * sigmoidf_(g1)));
                } }
        }
        __syncthreads();
    }
    if (smp || grp == 31) {
        float* o = out + (smp ? O_RS : O_RP) + (size_t)(b * NH + h) * (HD * HD);
#pragma unroll
        for (int vb = 0; vb < 8; ++vb)
#pragma unroll
            for (int r = 0; r < 4; ++r) ((GAS float*)o)[(16 * w + 4 * fq + r) * HD + 16 * vb + fr] = racc[vb][r];
    }
}

struct Args { const float* in[23]; float* out; unsigned char* ws; int ph_lo, ph_hi, li, pad; };
#define CAS __attribute__((address_space(4)))
__device__ __forceinline__ const CAS unsigned char* karg_base() { const CAS unsigned char* kp = (const CAS unsigned char*)__builtin_amdgcn_kernarg_segment_ptr(); asm volatile("" : "+s"(kp)); return kp; }
__device__ __forceinline__ const float* karg_in(int i) { return *(const float* const CAS*)(karg_base() + 8 * i); }
__device__ __forceinline__ float* karg_out() { return *(float* const CAS*)(karg_base() + 8 * 23); }
__device__ __forceinline__ unsigned char* karg_ws() { return *(unsigned char* const CAS*)(karg_base() + 8 * 24); }
__device__ __forceinline__ int karg_lo() { return *(const CAS int*)(karg_base() + 200); }
__device__ __forceinline__ int karg_hi() { return *(const CAS int*)(karg_base() + 204); }
#define PHASE_IDS() int tid = threadIdx.x; asm volatile("" : "+v"(tid)); const int lane = tid & 63, wave = __builtin_amdgcn_readfirstlane(tid >> 6); \
    const int G = gridDim.x, bx = blockIdx.x; (void)lane; (void)wave; (void)G; (void)bx
#define PHASE_GW() const int vcu = (G % 8 == 0) ? (bx % 8) * (G / 8) + bx / 8 : bx; const int gw = vcu * NWAVES + wave, NGW = G * NWAVES

__device__ __forceinline__ void ph_prologue(LAS unsigned char* lds) {
    PHASE_IDS(); PHASE_GW();
    unsigned char* ws = karg_ws();
    LAS float* scr = (LAS float*)(lds + RING_OFF + wave * 16384);
    constexpr int I_GU = (D / 64) * (FF / 32), I_DN = (FF / 64) * (D / 32), I_IN = (D / 64) * (DIN / 32), I_OUT = (D / 64) * (D / 32);
    constexpr int NITEMS = 4 * I_GU + 2 * I_DN + I_IN + I_OUT;
    for (int it = gw; it < NITEMS; it += NGW) {
        int r = it;
        if (r < I_GU) { p0_transpose_item(karg_in(5), D, FF, (bf16*)(ws + WS_WGU1), 1, scr, r, lane); continue; } r -= I_GU;
        if (r < I_GU) { p0_transpose_item(karg_in(6), D, FF, (bf16*)(ws + WS_WGU1), 2, scr, r, lane); continue; } r -= I_GU;
        if (r < I_DN) { p0_transpose_item(karg_in(7), FF, D, (bf16*)(ws + WS_WD1), 0, scr, r, lane); continue; } r -= I_DN;
        if (r < I_IN) { p0_transpose_item(karg_in(10), D, DIN, (bf16*)(ws + WS_WIN), 0, scr, r, lane); continue; } r -= I_IN;
        if (r < I_OUT) { p0_transpose_item(karg_in(16), D, D, (bf16*)(ws + WS_WOUT), 0, scr, r, lane); continue; } r -= I_OUT;
        if (r < I_GU) { p0_transpose_item(karg_in(19), D, FF, (bf16*)(ws + WS_WGU2), 1, scr, r, lane); continue; } r -= I_GU;
        if (r < I_GU) { p0_transpose_item(karg_in(20), D, FF, (bf16*)(ws + WS_WGU2), 2, scr, r, lane); continue; } r -= I_GU;
        p0_transpose_item(karg_in(21), FF, D, (bf16*)(ws + WS_WD2), 0, scr, r, lane);
    }
    const float* xp = karg_in(0); const float* xs = karg_in(1); const float* g = karg_in(4); bf16* Hb = (bf16*)(ws + WS_H);
    for (int m = gw; m < M; m += NGW) rms_row_to_bf16(m < MP ? xp + (size_t)m * D : xs + (size_t)(m - MP) * D, g, Hb + (size_t)m * D, lane);
}
template <int IT> __device__ __forceinline__ void ph_gateup(LAS unsigned char* lds) {
    unsigned char* ws = karg_ws();
    pg8::Gemm g{(const bf16*)(ws + WS_H), (const bf16*)(ws + (IT ? WS_WGU2 : WS_WGU1)), M, 2 * FF, D}; pg8::StaticOrder S; S.init(M, 2 * FF, (int)gridDim.x, (int)blockIdx.x);
    pg8::EpiSwiglu E{(bf16*)(ws + WS_ACT), FF};
    pg8::gemm_phase<pg8::EpiSwiglu, pg8::StaticOrder, PG8_ALIGN, PG8_SP2>(lds + RING_OFF, g, S, E);
}
template <int IT> __device__ __forceinline__ void ph_down(LAS unsigned char* lds) {
    unsigned char* ws = karg_ws();
    pg8::Gemm g{(const bf16*)(ws + WS_ACT), (const bf16*)(ws + (IT ? WS_WD2 : WS_WD1)), M, D, FF}; pg8::StaticOrder S; S.init(M, D, (int)gridDim.x, (int)blockIdx.x);
    pg8::EpiF32 E{(float*)(ws + WS_F), D};
    pg8::gemm_phase<pg8::EpiF32, pg8::StaticOrder, PG8_ALIGN, PG8_SP2>(lds + RING_OFF, g, S, E);
}
template <int WHICH> __device__ __forceinline__ void ph_norm() {
    PHASE_IDS(); PHASE_GW();
    unsigned char* ws = karg_ws(); float* Y = karg_out() + O_Y; const float* Fb = (const float*)(ws + WS_F); bf16* Hb = (bf16*)(ws + WS_H);
    const float* gpost = karg_in(WHICH == 0 ? 8 : (WHICH == 1 ? 17 : 22)); const float* gnext = WHICH == 2 ? nullptr : karg_in(WHICH == 0 ? 9 : 18);
    const float* xp = karg_in(0); const float* xs = karg_in(1);
    for (int m = gw; m < M; m += NGW) {
        const float* xr = WHICH == 0 ? (m < MP ? xp + (size_t)m * D : xs + (size_t)(m - MP) * D) : (const float*)(Y + (size_t)m * D);
        norm_row(Fb + (size_t)m * D, xr, WHICH == 1 ? 1.0f : 0.5f, gpost, Y + (size_t)m * D, gnext, Hb + (size_t)m * D, lane);
    }
}
__device__ __forceinline__ void ph_win(LAS unsigned char* lds) {
    unsigned char* ws = karg_ws();
    pg8::Gemm g{(const bf16*)(ws + WS_H), (const bf16*)(ws + WS_WIN), M, DIN, D}; pg8::StaticOrder S; S.init(M, DIN, (int)gridDim.x, (int)blockIdx.x);
    pg8::EpiBf16 E{(bf16*)(ws + WS_ACT), DIN};
    pg8::gemm_phase<pg8::EpiBf16, pg8::StaticOrder, PG8_ALIGN, PG8_SP2>(lds + RING_OFF, g, S, E);
}
__device__ __forceinline__ void ph_wout(LAS unsigned char* lds) {
    unsigned char* ws = karg_ws();
    pg8::Gemm g{(const bf16*)(ws + WS_H), (const bf16*)(ws + WS_WOUT), M, D, D}; pg8::StaticOrder S; S.init(M, D, (int)gridDim.x, (int)blockIdx.x);
    pg8::EpiF32 E{(float*)(ws + WS_F), D};
    pg8::gemm_phase<pg8::EpiF32, pg8::StaticOrder, PG8_ALIGN, PG8_SP2>(lds + RING_OFF, g, S, E);
}
__device__ __forceinline__ void ph_mix1(LAS unsigned char* lds) {
    PHASE_IDS();
    unsigned char* ws = karg_ws(); const bf16* Pb = (const bf16*)(ws + WS_ACT);
    if ((bx & 31) != 31) ret_pass_a(lds, Pb, bx, (float*)(ws + WS_F), tid, lane, wave);
    for (int cu = bx; cu < 520; cu += G) conv_unit(lds, cu, Pb, karg_in(2), karg_in(11), karg_in(12), karg_in(13), karg_in(14), (bf16*)(ws + WS_H), karg_out(), tid, lane, wave);
}
__device__ __forceinline__ void ph_mix2(LAS unsigned char* lds) {
    PHASE_IDS();
    unsigned char* ws = karg_ws();
#pragma unroll 1
    for (int k = 0; k < 2; ++k) {
        if (k == 1 && bx >= 32) break;
        ret_pass_b(lds, (const bf16*)(ws + WS_ACT), bx, k == 1, (const float*)(ws + WS_F), karg_in(3), karg_in(15), (bf16*)(ws + WS_H), karg_out(), tid, lane, wave);
    }
}

__global__ void __launch_bounds__(NWAVES * 64, 2) mk_fwd(Args args) {
    extern __shared__ __attribute__((aligned(16))) unsigned char lds_raw[];
    LAS unsigned char* lds = (LAS unsigned char*)lds_raw;
    volatile LAS unsigned* MISC = (volatile LAS unsigned*)(lds + MISC_OFF);
    for (int u = threadIdx.x; u < (LDS_BYTES - LDSCTL_OFF) / 4; u += NWAVES * 64) ((LAS unsigned*)(lds + LDSCTL_OFF))[u] = 0u;
    __syncthreads();
    gu32* ctl = (gu32*)(karg_ws() + WS_CTL);
    XcdBarrier bar; bar.bar = (unsigned*)(ctl + CW_BAR); bar.x = 0; bar.st = nullptr;
    if (N_LAUNCHES != PER_PHASE) bar = xcd_barrier_post((unsigned*)(ctl + CW_BAR), MISC + 8);
#define IN(k) (karg_lo() <= (k) && (k) < karg_hi())
#define SEAM(k) do { if (N_LAUNCHES != PER_PHASE && IN(k) && IN((k) + 1)) xcd_barrier(bar); } while (0)
    if (IN(0)) { ph_prologue(lds); SEAM(0); }
    if (IN(1)) { ph_gateup<0>(lds); SEAM(1); }
    if (IN(2)) { ph_down<0>(lds); SEAM(2); }
    if (IN(3)) { ph_norm<0>(); SEAM(3); }
    if (IN(4)) { ph_win(lds); SEAM(4); }
    if (IN(5)) { ph_mix1(lds); SEAM(5); }
    if (IN(6)) { ph_mix2(lds); SEAM(6); }
    if (IN(7)) { ph_wout(lds); SEAM(7); }
    if (IN(8)) { ph_norm<1>(); SEAM(8); }
    if (IN(9)) { ph_gateup<1>(lds); SEAM(9); }
    if (IN(10)) { ph_down<1>(lds); SEAM(10); }
    if (IN(11)) { ph_norm<2>(); }
#undef IN
#undef SEAM
    (void)args;
}

extern "C" void kernel_launch(void* const* d_in, const int* in_sizes, int n_in, void* d_out, int out_size, void* d_ws, size_t ws_size, hipStream_t stream) {
    static int grid = 0;
    if (grid == 0) {
        if (n_in != 23 || in_sizes[0] != MP * D || out_size != (int)O_END || ws_size < WS_END) { fprintf(stderr, "kernel_launch: unexpected shapes: n_in %d in0 %d out %d ws %zu; nothing launched\n", n_in, n_in > 0 ? in_sizes[0] : -1, out_size, ws_size); grid = -1; return; }
        int dev = 0, cus = 0, per_cu = 0;
        if (hipGetDevice(&dev) != hipSuccess || hipDeviceGetAttribute(&cus, hipDeviceAttributeMultiprocessorCount, dev) != hipSuccess) { fprintf(stderr, "kernel_launch: device query failed\n"); grid = -1; return; }
        if (hipFuncSetAttribute((const void*)mk_fwd, hipFuncAttributeMaxDynamicSharedMemorySize, LDS_BYTES) != hipSuccess) { fprintf(stderr, "kernel_launch: hipFuncSetAttribute failed\n"); grid = -1; return; }
        if (hipOccupancyMaxActiveBlocksPerMultiprocessor(&per_cu, (const void*)mk_fwd, NWAVES * 64, LDS_BYTES) != hipSuccess || per_cu < 1)
            fprintf(stderr, "kernel_launch: note: occupancy query reports %d workgroups per CU\n", per_cu);
        (void)hipGetLastError();
        grid = cus;
        if (grid != 256) fprintf(stderr, "kernel_launch: %d CUs; this kernel is laid out for 256\n", grid);
    }
    if (grid < 0) return;
    if (hipMemsetAsync((char*)d_ws + WS_CTL, 0, CTL_ZERO_BYTES, stream) != hipSuccess) { fprintf(stderr, "kernel_launch: hipMemsetAsync failed\n"); return; }
    Args a{};
    for (int i = 0; i < 23; ++i) a.in[i] = (const float*)d_in[i];
    a.out = (float*)d_out; a.ws = (unsigned char*)d_ws;
    for (int li = 0; li < N_LAUNCHES; ++li) {
        a.ph_lo = (N_LAUNCHES == PER_PHASE) ? li : 0; a.ph_hi = (N_LAUNCHES == PER_PHASE) ? li + 1 : PER_PHASE; a.li = li;
        hipLaunchKernelGGL(mk_fwd, dim3(grid), dim3(NWAVES * 64), LDS_BYTES, stream, a);
        const hipError_t le = hipPeekAtLastError();
        if (le != hipSuccess) { fprintf(stderr, "kernel_launch: launch %d failed: %s\n", li, hipGetErrorName(le)); break; }
    }
}
```

```cpp
#include <hip/hip_runtime.h>
#include <cstdio>
#include <cstdint>
namespace pg8 {
#define PG8_LAS __attribute__((address_space(3)))
typedef unsigned short bf16_t;
typedef short bf16x8 __attribute__((ext_vector_type(8)));
typedef float f32x4 __attribute__((ext_vector_type(4)));
typedef unsigned u32x4 __attribute__((ext_vector_type(4)));
constexpr int BM = 256, BK = 64, HALF = 128, HTB = HALF * BK * 2  , STAGE_BYTES = 8 * HTB, NXCD = 8, WGM = 8;

__host__ __device__ __forceinline__ int lds_byte(int r, int c) { const int st = (r >> 4) * 2 + (c >> 5), rr = r & 15, cc = c & 31, ob = rr * 64 + cc * 2; return st * 1024 + (ob ^ (((ob >> 9) & 1) << 5)); }
__host__ __device__ __forceinline__ void stage_rc(int b, int& R, int& C) { const int st = b / 1024, sb = b % 1024, swz = sb ^ (((sb >> 9) & 1) << 5); R = (st >> 1) * 16 + swz / 64; C = (st & 1) * 32 + (swz % 64) / 2; }
__host__ __device__ __forceinline__ int perm32(int rho) { const int n = rho >> 4, i = rho & 15; return 8 * (i >> 2) + 4 * n + (i & 3); }

struct Unit { int pm, pn, koff, nt, slab; };
struct Gemm { const bf16_t* A; const bf16_t* Bt; int M, N, K; };

struct StaticOrder {
    int nM, nN, nwg, G, c, ntF;
    int nS, nks, ntS, pmS;
    __host__ __device__ void init(int M, int N, int K, int G_, int c_) { nM = M / BM; nN = N / BM; nwg = nM * nN; G = G_; c = c_; ntF = K / BK; nS = 0; nks = 1; ntS = ntF; pmS = 0; }
    __host__ __device__ void extra(int pm, int nks_) { pmS = pm; nks = nks_; ntS = ntF / nks_; nS = nN * nks_; }
    __host__ __device__ bool next(int i, Unit& u) const {
        const long L = (long)i * G + c; if (L >= nwg + nS) return false;
        if (L >= nwg) { const int s = (int)L - nwg, ks = s % nks; u.pm = pmS; u.pn = s / nks; u.koff = ks * ntS * BK; u.nt = ntS; u.slab = nks > 1 ? ks : -1; return true; }
        int wgid = (int)L; { const int q = nwg / NXCD, r = nwg % NXCD, xcd = wgid % NXCD, off = wgid / NXCD; wgid = (xcd < r ? xcd * (q + 1) : r * (q + 1) + (xcd - r) * q) + off; }
        const int nig = WGM * nN, gid = wgid / nig, fm = gid * WGM, gsz = (nM - fm) < WGM ? (nM - fm) : WGM;
        u.pm = fm + ((wgid % nig) % gsz); u.pn = (wgid % nig) / gsz; u.koff = 0; u.nt = ntF; u.slab = -1; return true;
    }
    __device__ __forceinline__ void a_ready(const Unit&) const {}
    __device__ __forceinline__ void done(const Unit&) const {}
};

__device__ __forceinline__ unsigned cvt_pk_bf16(float lo, float hi) { unsigned r; asm volatile("v_cvt_pk_bf16_f32 %0, %1, %2" : "=v"(r) : "v"(lo), "v"(hi)); return r; }
__device__ __forceinline__ float fast_sigmoid(float x) { return __builtin_amdgcn_rcpf(1.0f + __builtin_amdgcn_exp2f(x * -1.44269504089f)); }
__device__ __forceinline__ float fast_silu(float x) { return x * fast_sigmoid(x); }

struct EpiF32 {
    static constexpr bool PERM = false, AFTER_DRAIN = false;
    float* C; int ldc; float* slab;
    __device__ __forceinline__ void operator()(const f32x4 (&acc)[2][2][4][2], const Unit& u, int wr, int wc, int fr, int fq) const {
        const int row0 = wr * 64 + fr, col0 = u.pn * BM + wc * 32 + 4 * fq;
        float* base = u.slab >= 0 ? slab + (size_t)u.slab * BM * ldc : C + (size_t)u.pm * BM * ldc;
#pragma unroll
        for (int ai = 0; ai < 2; ++ai)
#pragma unroll
            for (int m = 0; m < 4; ++m) { float* rowp = base + (size_t)(row0 + ai * HALF + m * 16) * ldc + col0;
#pragma unroll
                for (int bj = 0; bj < 2; ++bj)
#pragma unroll
                    for (int n = 0; n < 2; ++n) *(f32x4*)(rowp + bj * HALF + n * 16) = acc[ai][bj][m][n]; }
    }
};
struct EpiBf16 {
    static constexpr bool PERM = true, AFTER_DRAIN = false;
    bf16_t* O; int ldc; float* slab;
    __device__ __forceinline__ void operator()(const f32x4 (&acc)[2][2][4][2], const Unit& u, int wr, int wc, int fr, int fq) const {
        const int row0 = wr * 64 + fr, col0 = u.pn * BM + wc * 32 + 8 * fq;
        if (u.slab >= 0) {
            float* base = slab + (size_t)u.slab * BM * ldc;
#pragma unroll
            for (int ai = 0; ai < 2; ++ai)
#pragma unroll
                for (int m = 0; m < 4; ++m) { float* rowp = base + (size_t)(row0 + ai * HALF + m * 16) * ldc + col0;
#pragma unroll
                    for (int bj = 0; bj < 2; ++bj)
#pragma unroll
                        for (int n = 0; n < 2; ++n) *(f32x4*)(rowp + bj * HALF + n * 4) = acc[ai][bj][m][n]; }
            return;
        }
#pragma unroll
        for (int ai = 0; ai < 2; ++ai)
#pragma unroll
            for (int m = 0; m < 4; ++m) { bf16_t* rowp = O + (size_t)(u.pm * BM + row0 + ai * HALF + m * 16) * ldc + col0;
#pragma unroll
                for (int bj = 0; bj < 2; ++bj) { const f32x4 v0 = acc[ai][bj][m][0], v1 = acc[ai][bj][m][1];
                    u32x4 w; w.x = cvt_pk_bf16(v0[0], v0[1]); w.y = cvt_pk_bf16(v0[2], v0[3]); w.z = cvt_pk_bf16(v1[0], v1[1]); w.w = cvt_pk_bf16(v1[2], v1[3]);
                    *(u32x4*)(rowp + bj * HALF) = w; } }
    }
};
struct EpiSwiglu {
    static constexpr bool PERM = true, AFTER_DRAIN = false;
    bf16_t* O; int ldc;
    __device__ __forceinline__ void operator()(const f32x4 (&acc)[2][2][4][2], const Unit& u, int wr, int wc, int fr, int fq) const {
        const int row0 = u.pm * BM + wr * 64 + fr, col0 = u.pn * HALF + wc * 32 + 8 * fq;
#pragma unroll
        for (int ai = 0; ai < 2; ++ai)
#pragma unroll
            for (int m = 0; m < 4; ++m) { bf16_t* rowp = O + (size_t)(row0 + ai * HALF + m * 16) * ldc + col0;
                const f32x4 g0 = acc[ai][0][m][0], g1 = acc[ai][0][m][1], u0 = acc[ai][1][m][0], u1 = acc[ai][1][m][1];
                u32x4 w; w.x = cvt_pk_bf16(fast_silu(g0[0]) * u0[0], fast_silu(g0[1]) * u0[1]); w.y = cvt_pk_bf16(fast_silu(g0[2]) * u0[2], fast_silu(g0[3]) * u0[3]);
                w.z = cvt_pk_bf16(fast_silu(g1[0]) * u1[0], fast_silu(g1[1]) * u1[1]); w.w = cvt_pk_bf16(fast_silu(g1[2]) * u1[2], fast_silu(g1[3]) * u1[3]);
                *(u32x4*)rowp = w; }
    }
};

template <class Epi, class Sched, bool ALIGN_EPI = false, bool SP2 = false>
__device__ __forceinline__ void gemm_phase(PG8_LAS unsigned char* lds, const Gemm g, const Sched& S, const Epi& E) {
    int tid_ = threadIdx.x; asm volatile("" : "+v"(tid_)); const int tid = tid_, wid = __builtin_amdgcn_readfirstlane(tid >> 6), lane = tid & 63, wr = wid >> 2, wc = wid & 3, fr = lane & 15, fq = lane >> 4;
    const int K = g.K;
    unsigned voffA[2], voffB[2];
#pragma unroll
    for (int i = 0; i < 2; ++i) { int R, C; stage_rc(tid * 16 + i * 8192, R, C); const int Rb = Epi::PERM ? ((R & ~31) + perm32(R & 31)) : R;
        voffA[i] = (unsigned)(R * K + C) * 2u; voffB[i] = (unsigned)(Rb * K + C) * 2u; }
    const size_t kstep = (size_t)(BK * 2);
    const size_t hstep = (size_t)HALF * K * 2;
    const size_t tstep = 2 * hstep;
    const unsigned ldsw = (unsigned)wid * 1024u;
    const int aoff = lds_byte(wr * 64 + fr, fq * 8), boff = lds_byte(wc * 32 + fr, fq * 8);
#define PG8_SA(b, h) (((b) * 2 + (h)) * HTB)
#define PG8_SB(b, h) ((4 + (b) * 2 + (h)) * HTB)
#define PG8_STAGE(bufoff, gbase, voff) do { _Pragma("unroll") for (int _i = 0; _i < 2; ++_i) \
        __builtin_amdgcn_global_load_lds((const unsigned*)((const char*)(gbase) + (voff)[_i]), (PG8_LAS unsigned*)(lds + (bufoff) + ldsw + _i * 8192), 16, 0, 0); } while (0)
#define PG8_LDA(dst, b, h) do { _Pragma("unroll") for (int m = 0; m < 4; ++m) _Pragma("unroll") for (int k = 0; k < 2; ++k) dst[m][k] = *(const PG8_LAS bf16x8*)(lds + PG8_SA(b, h) + aoff + m * 2048 + k * 1024); } while (0)
#define PG8_LDB(dst, b, h) do { _Pragma("unroll") for (int n = 0; n < 2; ++n) _Pragma("unroll") for (int k = 0; k < 2; ++k) dst[n][k] = *(const PG8_LAS bf16x8*)(lds + PG8_SB(b, h) + boff + n * 2048 + k * 1024); } while (0)
#define PG8_MMA(ai, bj, At, Bt) do { __builtin_amdgcn_s_setprio(1); _Pragma("unroll") for (int m = 0; m < 4; ++m) _Pragma("unroll") for (int n = 0; n < 2; ++n) _Pragma("unroll") for (int k = 0; k < 2; ++k) \
        acc[ai][bj][m][n] = __builtin_amdgcn_mfma_f32_16x16x32_bf16(Bt[n][k], At[m][k], acc[ai][bj][m][n], 0, 0, 0); __builtin_amdgcn_s_setprio(0); } while (0)
#define PG8_WAIT_V(n) asm volatile("s_waitcnt vmcnt(" #n ")" ::: "memory")
#define PG8_WAIT_L(n) asm volatile("s_waitcnt lgkmcnt(" #n ")" ::: "memory")
#define PG8_BAR __builtin_amdgcn_s_barrier()
#define PG8_SCHED __builtin_amdgcn_sched_barrier(0)
    Unit cur, nxt; int ui = 0;
    if (!S.next(0, cur)) return;
    f32x4 acc[2][2][4][2];
#pragma unroll
    for (int a = 0; a < 2; ++a)
#pragma unroll
        for (int b = 0; b < 2; ++b)
#pragma unroll
            for (int m = 0; m < 4; ++m)
#pragma unroll
                for (int n = 0; n < 2; ++n) acc[a][b][m][n] = (f32x4){0.f, 0.f, 0.f, 0.f};
    bf16x8 At[4][2], B0[2][2], B1[2][2];
    const char* cA = (const char*)g.A + (size_t)cur.pm * tstep + (size_t)cur.koff * 2; const char* cB = (const char*)g.Bt + (size_t)cur.pn * tstep + (size_t)cur.koff * 2;
    S.a_ready(cur);
    if constexpr (SP2) {
        PG8_STAGE(PG8_SB(0, 0), cB, voffB); PG8_STAGE(PG8_SB(0, 1), cB + hstep, voffB); PG8_STAGE(PG8_SA(0, 0), cA, voffA); PG8_STAGE(PG8_SA(0, 1), cA + hstep, voffA);
        if (wr == 1) PG8_BAR;
        PG8_WAIT_V(2); PG8_BAR;
        PG8_STAGE(PG8_SB(1, 0), cB + kstep, voffB); PG8_STAGE(PG8_SA(1, 0), cA + kstep, voffA); PG8_STAGE(PG8_SB(1, 1), cB + hstep + kstep, voffB);
        PG8_WAIT_V(6); PG8_BAR;
    } else {
        PG8_STAGE(PG8_SB(0, 0), cB, voffB); PG8_STAGE(PG8_SA(0, 0), cA, voffA); PG8_STAGE(PG8_SB(0, 1), cB + hstep, voffB); PG8_STAGE(PG8_SA(0, 1), cA + hstep, voffA);
        if (wr == 1) PG8_BAR;
        PG8_WAIT_V(4); PG8_BAR;
        PG8_STAGE(PG8_SB(1, 0), cB + kstep, voffB); PG8_STAGE(PG8_SA(1, 0), cA + kstep, voffA); PG8_STAGE(PG8_SB(1, 1), cB + hstep + kstep, voffB);
        PG8_WAIT_V(6); PG8_BAR;
    }
    for (;;) {
        const bool has_next = S.next(ui + 1, nxt);
        const char* nA = has_next ? (const char*)g.A + (size_t)nxt.pm * tstep + (size_t)nxt.koff * 2 : cA; const char* nB = has_next ? (const char*)g.Bt + (size_t)nxt.pn * tstep + (size_t)nxt.koff * 2 : cB;
        const int nt = cur.nt;
        for (int t = 0; t < nt; t += 2) {
            const bool last = (t == nt - 2);
            const char* a1 = cA + (size_t)(t + 1) * kstep;
            const char* a2 = last ? nA : cA + (size_t)(t + 2) * kstep; const char* b2 = last ? nB : cB + (size_t)(t + 2) * kstep;
            const char* a3 = a2 + kstep; const char* b3 = b2 + kstep;
            if (last && has_next) S.a_ready(nxt);
            if constexpr (SP2) {
            PG8_LDB(B0, 0, 0); PG8_LDB(B1, 0, 1); PG8_SCHED; PG8_LDA(At, 0, 0); PG8_STAGE(PG8_SA(1, 1), a1 + hstep, voffA);
            PG8_WAIT_V(8); PG8_WAIT_L(0); PG8_BAR; PG8_MMA(0, 0, At, B0); PG8_MMA(0, 1, At, B1); PG8_BAR; PG8_SCHED;
            PG8_LDA(At, 0, 1); PG8_STAGE(PG8_SB(0, 0), b2, voffB); PG8_STAGE(PG8_SB(0, 1), b2 + hstep, voffB); PG8_STAGE(PG8_SA(0, 0), a2, voffA);
            PG8_WAIT_V(8); PG8_WAIT_L(0); PG8_BAR; PG8_MMA(1, 0, At, B0); PG8_MMA(1, 1, At, B1); PG8_BAR; PG8_SCHED;
            PG8_LDB(B0, 1, 0); PG8_LDB(B1, 1, 1); PG8_SCHED; PG8_LDA(At, 1, 0); PG8_STAGE(PG8_SA(0, 1), a2 + hstep, voffA);
            PG8_WAIT_V(8); PG8_WAIT_L(0); PG8_BAR; PG8_MMA(0, 0, At, B0); PG8_MMA(0, 1, At, B1); PG8_BAR; PG8_SCHED;
            PG8_LDA(At, 1, 1); PG8_STAGE(PG8_SB(1, 0), b3, voffB); PG8_STAGE(PG8_SB(1, 1), b3 + hstep, voffB); PG8_STAGE(PG8_SA(1, 0), a3, voffA);
            PG8_WAIT_V(8); PG8_WAIT_L(0); PG8_BAR; PG8_MMA(1, 0, At, B0); PG8_MMA(1, 1, At, B1); PG8_BAR; PG8_SCHED;
            } else {
            PG8_LDB(B0, 0, 0); PG8_SCHED; PG8_LDA(At, 0, 0); PG8_STAGE(PG8_SA(1, 1), a1 + hstep, voffA);
            PG8_WAIT_L(8); PG8_BAR; PG8_WAIT_L(0); PG8_MMA(0, 0, At, B0); PG8_BAR; PG8_SCHED;
            PG8_LDB(B1, 0, 1); PG8_STAGE(PG8_SB(0, 0), b2, voffB);
            PG8_BAR; PG8_WAIT_L(0); PG8_MMA(0, 1, At, B1); PG8_BAR;
            PG8_LDA(At, 0, 1); PG8_STAGE(PG8_SA(0, 0), a2, voffA);
            PG8_BAR; PG8_WAIT_L(0); PG8_MMA(1, 0, At, B0); PG8_BAR; PG8_SCHED;
            PG8_STAGE(PG8_SB(0, 1), b2 + hstep, voffB);
            PG8_WAIT_V(6); PG8_BAR; PG8_MMA(1, 1, At, B1); PG8_BAR;
            PG8_LDB(B0, 1, 0); PG8_SCHED; PG8_LDA(At, 1, 0); PG8_STAGE(PG8_SA(0, 1), a2 + hstep, voffA);
            PG8_WAIT_L(8); PG8_BAR; PG8_WAIT_L(0); PG8_MMA(0, 0, At, B0); PG8_BAR; PG8_SCHED;
            PG8_LDB(B1, 1, 1); PG8_STAGE(PG8_SB(1, 0), b3, voffB);
            PG8_BAR; PG8_WAIT_L(0); PG8_MMA(0, 1, At, B1); PG8_BAR;
            PG8_LDA(At, 1, 1); PG8_STAGE(PG8_SA(1, 0), a3, voffA);
            PG8_BAR; PG8_WAIT_L(0); PG8_MMA(1, 0, At, B0); PG8_BAR; PG8_SCHED;
            PG8_STAGE(PG8_SB(1, 1), b3 + hstep, voffB);
            PG8_WAIT_V(6); PG8_BAR; PG8_MMA(1, 1, At, B1); PG8_BAR;
            }
        }
        if constexpr (ALIGN_EPI) { if (wr == 0) PG8_BAR; }
        if constexpr (!Epi::AFTER_DRAIN) { E(acc, cur, wr, wc, fr, fq); S.done(cur); }
        if (!has_next) break;
#pragma unroll
        for (int a = 0; a < 2; ++a)
#pragma unroll
            for (int b = 0; b < 2; ++b)
#pragma unroll
                for (int m = 0; m < 4; ++m)
#pragma unroll
                    for (int n = 0; n < 2; ++n) acc[a][b][m][n] = (f32x4){0.f, 0.f, 0.f, 0.f};
        cur = nxt; cA = nA; cB = nB; ++ui;
        if constexpr (ALIGN_EPI) { if (wr == 1) PG8_BAR; }
    }
    PG8_WAIT_V(0);
    if constexpr (!ALIGN_EPI) { if (wr == 0) PG8_BAR; }
    PG8_BAR;
    if constexpr (Epi::AFTER_DRAIN) { E.fused(acc, cur, wr, wc, fr, fq, lds, wid, lane); S.done(cur); }
#undef PG8_SA
#undef PG8_SB
#undef PG8_STAGE
#undef PG8_LDA
#undef PG8_LDB
#undef PG8_MMA
#undef PG8_WAIT_V
#undef PG8_WAIT_L
#undef PG8_BAR
#undef PG8_SCHED
}
}

#ifndef PG8_SP2
#define PG8_SP2 true
#endif
#ifndef PG8_ALIGN
#define PG8_ALIGN true
#endif

constexpr int NWAVES = 8;
#ifndef MK_N_LAUNCHES
#define MK_N_LAUNCHES 1
#endif
constexpr int PER_PHASE = 12;
constexpr int N_LAUNCHES = MK_N_LAUNCHES;

constexpr int MP = 16384, MS = 256, M = MP + MS;
constexpr int D = 1024, FF = 2816, DIN = 3072, DC = 512, NH = 4, HD = 128, TP = 8192, TS = 32, CWID = 31, PAST = 4096;
constexpr float EPS = 1e-6f;
constexpr size_t O_Y = 0, O_CP = (size_t)M * D, O_RP = O_CP + 2 * 30 * DC, O_CS = O_RP + 2 * NH * HD * HD, O_RS = O_CS + 8 * 30 * DC, O_END = O_RS + 8 * NH * HD * HD;
static_assert(O_END == 17848320, "output size");

constexpr size_t MiB = 1u << 20;
constexpr size_t WS_CTL = 0, CTL_ZERO_BYTES = 1 * MiB;
constexpr size_t WS_WGU1 = 1 * MiB, WS_WD1 = 12 * MiB, WS_WIN = WS_WD1 + 5632 * 1024, WS_WOUT = WS_WIN + 6 * MiB, WS_WGU2 = WS_WOUT + 2 * MiB, WS_WD2 = WS_WGU2 + 11 * MiB;
constexpr size_t WS_H = 42 * MiB;
constexpr size_t WS_ACT = 75 * MiB;
constexpr size_t WS_F = 173 * MiB;
constexpr size_t WS_SLAB = 238 * MiB;
constexpr size_t WS_END = WS_SLAB + (size_t)4 * 256 * DIN * 4;
constexpr int NKS_DOWN = 11, NKS_IN = 4, NKS_OUT = 4;
static_assert(WS_WD2 + (size_t)D * FF * 2 <= WS_H && WS_H + (size_t)M * D * 2 <= WS_ACT && WS_ACT + (size_t)M * DIN * 2 <= WS_F && WS_F + (size_t)M * D * 4 <= WS_SLAB && (size_t)NKS_DOWN * 256 * D * 4 <= WS_END - WS_SLAB && WS_END <= 256 * MiB, "d_ws map");
constexpr int CW_BAR = 4096;

constexpr int RING_OFF = 0, RING_BYTES = 131072;
constexpr int LDSCTL_OFF = RING_BYTES, MISC_OFF = LDSCTL_OFF + 320;
constexpr int LDS_BYTES = 147456;
static_assert(MISC_OFF + 128 <= LDS_BYTES, "LDS map");
#define GAS __attribute__((address_space(1)))
#define LAS __attribute__((address_space(3)))
typedef unsigned short bf16;
typedef unsigned v4u __attribute__((ext_vector_type(4)));
typedef float f32x4 __attribute__((ext_vector_type(4)));
typedef short bf16x8 __attribute__((ext_vector_type(8)));
typedef GAS unsigned gu32;
typedef GAS unsigned long long gu64;
#define RLX_AGENT __ATOMIC_RELAXED, __HIP_MEMORY_SCOPE_AGENT
#define LDS_WAIT() asm volatile("s_waitcnt lgkmcnt(0)" ::: "memory")
#define VM_WAIT() asm volatile("s_waitcnt vmcnt(0)" ::: "memory")
__device__ __forceinline__ unsigned long long rt() { return __builtin_amdgcn_s_memrealtime(); }
__device__ __forceinline__ unsigned f2bf(float f) { unsigned u = __builtin_bit_cast(unsigned, f); return (u + 0x7fffu + ((u >> 16) & 1u)) >> 16; }
__device__ __forceinline__ unsigned pk2(float lo, float hi) { return f2bf(lo) | (f2bf(hi) << 16); }

#define XB_TMO      128
#define XB_XCNT(j)  (256  + 64 * (j))
#define XB_XSUB(j)  (1280 + 64 * (j))
#define XB_XGEN(j)  (2304 + 64 * (j))
#define XB_TOP      3328
#define XB_TOPGEN   3392
#define XCD_BAR_WORDS 3456
#define XB_SPIN_CAP (1u << 18)

__device__ __forceinline__ unsigned xb_ld(unsigned* p)              { return __hip_atomic_load(p, __ATOMIC_RELAXED, __HIP_MEMORY_SCOPE_AGENT); }
__device__ __forceinline__ unsigned xb_add(unsigned* p, unsigned v) { return __hip_atomic_fetch_add(p, v, __ATOMIC_RELAXED, __HIP_MEMORY_SCOPE_AGENT); }
__device__ __forceinline__ unsigned xb_xcc_id() { return (unsigned)__builtin_amdgcn_s_getreg((3 << 11) | 20) & 0xFu; }
#define XB_SPIN(cond, bar) do { unsigned _sp = 0; while (cond) { __builtin_amdgcn_s_sleep(1); \
    if ((++_sp & 255u) == 0u) { if (xb_ld(&(bar)[XB_TMO])) break; if (_sp > XB_SPIN_CAP) { atomicAdd(&(bar)[XB_TMO], 1u); break; } } } } while (0)

struct XcdBarrier {
    unsigned* bar; unsigned x;
    volatile LAS unsigned* st;
};

__device__ __forceinline__ XcdBarrier xcd_barrier_post(unsigned* bar, volatile LAS unsigned* st) {
    XcdBarrier b; b.bar = bar; b.x = xb_xcc_id(); b.st = st;
    if (threadIdx.x == 0) (void)xb_add(&bar[XB_XCNT(b.x)], 1u);
    return b;
}
__device__ __forceinline__ void xcd_barrier_complete(unsigned* bar, unsigned x, unsigned& nloc, unsigned& nx) {
    const unsigned G = gridDim.x * gridDim.y * gridDim.z;
    unsigned sum, cnt, mine, sp = 0u;
    for (;;) {
        sum = 0u; cnt = 0u; mine = 0u;
#pragma unroll
        for (unsigned j = 0; j < 16; ++j) { const unsigned c = xb_ld(&bar[XB_XCNT(j)]); sum += c; cnt += (c > 0u) ? 1u : 0u; mine = (j == x) ? c : mine; }
        if (sum == G) break;
        __builtin_amdgcn_s_sleep(1);
        if ((++sp & 255u) == 0u) { if (xb_ld(&bar[XB_TMO])) break; if (sp > XB_SPIN_CAP) { atomicAdd(&bar[XB_TMO], 1u); break; } }
    }
    nloc = mine > 0u ? mine : 1u; nx = cnt > 0u ? cnt : 1u;
}

__device__ __forceinline__ void xcd_barrier(const XcdBarrier& b) {
    asm volatile("s_waitcnt vmcnt(0)" ::: "memory");
    __syncthreads();
    if (threadIdx.x == 0) {
        unsigned* bar = b.bar;
        __builtin_amdgcn_s_waitcnt(0);
        unsigned nloc = b.st[0], nx = b.st[1];
        if (nloc == 0u) { xcd_barrier_complete(bar, b.x, nloc, nx); b.st[0] = nloc; b.st[1] = nx; }
        const unsigned old = xb_add(&bar[XB_XSUB(b.x)], 1u);
        const unsigned gen = old / nloc;
        if (old + 1u == (gen + 1u) * nloc) {
            __builtin_amdgcn_fence(__ATOMIC_RELEASE, "agent");
            asm volatile("s_waitcnt vmcnt(0)" ::: "memory");
            const unsigned og = xb_add(&bar[XB_TOP], 1u);
            const unsigned tg = og / nx;
            if (og + 1u == (tg + 1u) * nx) xb_add(&bar[XB_TOPGEN], 1u);
            else XB_SPIN(xb_ld(&bar[XB_TOPGEN]) == tg, bar);
            __builtin_amdgcn_fence(__ATOMIC_ACQUIRE, "agent");
            xb_add(&bar[XB_XGEN(b.x)], 1u);
            asm volatile("s_waitcnt vmcnt(0)" ::: "memory");
        } else {
            XB_SPIN(xb_ld(&bar[XB_XGEN(b.x)]) == gen, bar);
            __builtin_amdgcn_fence(__ATOMIC_ACQUIRE, "agent");
            asm volatile("s_waitcnt vmcnt(0)" ::: "memory");
        }
    }
    __syncthreads();
}


typedef float f32x2 __attribute__((ext_vector_type(2)));
typedef unsigned u32x2 __attribute__((ext_vector_type(2)));
__device__ __forceinline__ float wave_sum(float v) {
#pragma unroll
    for (int o = 1; o < 64; o <<= 1) v += __shfl_xor(v, o);
    return v;
}
__device__ __forceinline__ float bf_lo(unsigned w) { return __builtin_bit_cast(float, w << 16); }
__device__ __forceinline__ float bf_hi(unsigned w) { return __builtin_bit_cast(float, w & 0xffff0000u); }
__device__ __forceinline__ float bf1(bf16 b) { return __builtin_bit_cast(float, (unsigned)b << 16); }
__device__ __forceinline__ float sigmoidf_(float x) { return 1.0f / (1.0f + __expf(-x)); }

__device__ __forceinline__ void p0_transpose_item(const float* W, int K, int N, bf16* WT, int mode, LAS float* scr, int item, int lane) {
    const int nblk = N / 32, kb = item / nblk, nb = item % nblk, k0 = 64 * kb, n0 = 32 * nb;
#pragma unroll 8
    for (int i = 0; i < 32; ++i) { const int kk = 2 * i + (lane >> 5); scr[kk * 33 + (lane & 31)] = W[(size_t)(k0 + kk) * N + n0 + (lane & 31)]; }
    LDS_WAIT(); asm volatile("" ::: "memory");
    const int r0 = (mode == 0) ? n0 : ((n0 >> 7) * 256 + (n0 & 127) + (mode == 2 ? 128 : 0));
    const int c = lane & 7;
#pragma unroll
    for (int j = 0; j < 4; ++j) { const int n = (lane >> 3) + 8 * j; const LAS float* s = scr + (8 * c) * 33 + n;
        v4u o; o.x = pk2(s[0 * 33], s[1 * 33]); o.y = pk2(s[2 * 33], s[3 * 33]); o.z = pk2(s[4 * 33], s[5 * 33]); o.w = pk2(s[6 * 33], s[7 * 33]);
        *(GAS v4u*)(WT + (size_t)(r0 + n) * K + k0 + 8 * c) = o; }
    LDS_WAIT(); asm volatile("" ::: "memory");
}
__device__ __forceinline__ void rms_row_to_bf16(const float* xrow, const float* gain, bf16* orow, int lane) {
    const GAS f32x4* xr = (const GAS f32x4*)xrow + lane; const GAS f32x4* gr = (const GAS f32x4*)gain + lane;
    f32x4 v[4]; float s = 0.f;
#pragma unroll
    for (int j = 0; j < 4; ++j) { v[j] = xr[64 * j]; s += (v[j].x * v[j].x + v[j].y * v[j].y) + (v[j].z * v[j].z + v[j].w * v[j].w); }
    const float rstd = 1.f / sqrtf(wave_sum(s) * (1.f / D) + EPS);
    GAS unsigned long long* o8 = (GAS unsigned long long*)orow + lane;
#pragma unroll
    for (int j = 0; j < 4; ++j) { const f32x4 g = gr[64 * j];
        o8[64 * j] = (unsigned long long)pk2(v[j].x * rstd * g.x, v[j].y * rstd * g.y) | ((unsigned long long)pk2(v[j].z * rstd * g.z, v[j].w * rstd * g.w) << 32); }
}

__device__ __forceinline__ void norm_row(const float* frow, int nsl, size_t sl_stride, const float* xrow, float scale, const float* gpost, float* yrow, const float* gnext, bf16* hrow, int lane) {
    const GAS f32x4* fr_ = (const GAS f32x4*)frow + lane; const GAS f32x4* xr = (const GAS f32x4*)xrow + lane; const GAS f32x4* gp = (const GAS f32x4*)gpost + lane;
    f32x4 f[4], x[4]; float s = 0.f;
#pragma unroll
    for (int j = 0; j < 4; ++j) { f[j] = fr_[64 * j]; x[j] = xr[64 * j]; }
    for (int k = 1; k < nsl; ++k) {
#pragma unroll
        for (int j = 0; j < 4; ++j) f[j] = f[j] + fr_[k * (sl_stride / 4) + 64 * j]; }
#pragma unroll
    for (int j = 0; j < 4; ++j) s += (f[j].x * f[j].x + f[j].y * f[j].y) + (f[j].z * f[j].z + f[j].w * f[j].w);
    const float rf = scale / sqrtf(wave_sum(s) * (1.f / D) + EPS);
    float s2 = 0.f;
    GAS f32x4* yo = (GAS f32x4*)yrow + lane;
#pragma unroll
    for (int j = 0; j < 4; ++j) { const f32x4 g = gp[64 * j]; x[j] = x[j] + f[j] * g * rf; yo[64 * j] = x[j];
        s2 += (x[j].x * x[j].x + x[j].y * x[j].y) + (x[j].z * x[j].z + x[j].w * x[j].w); }
    if (gnext) {
        const float rstd = 1.f / sqrtf(wave_sum(s2) * (1.f / D) + EPS);
        const GAS f32x4* gn = (const GAS f32x4*)gnext + lane; GAS unsigned long long* o8 = (GAS unsigned long long*)hrow + lane;
#pragma unroll
        for (int j = 0; j < 4; ++j) { const f32x4 g = gn[64 * j];
            o8[64 * j] = (unsigned long long)pk2(x[j].x * rstd * g.x, x[j].y * rstd * g.y) | ((unsigned long long)pk2(x[j].z * rstd * g.z, x[j].w * rstd * g.w) << 32); }
    }
}

constexpr int CS_LD = 516;
__device__ __forceinline__ void conv_unit(LAS unsigned char* lds, int cu, const bf16* P, const float* state_conv, const float* conv_w, const float* conv_b,
                                          const float* ln_g, const float* ln_b, bf16* MIX, float* out, int tid, int lane, int wave) {
    const bool smp = cu >= 512; const int b = smp ? cu - 512 : cu >> 8, T0 = smp ? 0 : (cu & 255) * 32;
    const size_t rb = smp ? (size_t)MP + b * TS : (size_t)b * TP;
    const bool tail = smp || (cu & 255) == 255;
    float* nh = out + (smp ? O_CS : O_CP) + (size_t)b * 30 * DC;
    const int ch = tid;
    float w[CWID], acc[32];
#pragma unroll
    for (int j = 0; j < CWID; ++j) w[j] = conv_w[j * DC + ch];
    const float bias = conv_b[ch];
#pragma unroll
    for (int t = 0; t < 32; ++t) acc[t] = bias;
#pragma unroll
    for (int ee = 0; ee < 62; ++ee) {
        const int ts = T0 + ee - 30;
        float v;
        if (ts >= 0) { const bf16* pr = P + (rb + ts) * DIN; const float a = bf1(((const GAS bf16*)pr)[ch]), g = bf1(((const GAS bf16*)pr)[DC + ch]); v = a * sigmoidf_(g); }
        else v = smp ? state_conv[((size_t)b * 30 + (30 + ts)) * DC + ch] : 0.f;
        if (tail && ee >= 32) nh[(size_t)(ee - 32) * DC + ch] = v;
#pragma unroll
        for (int t = 0; t < 32; ++t) { const int j = ee - t; if (j >= 0 && j < CWID) acc[t] += w[j] * v; }
    }
    LAS float* cs = (LAS float*)lds;
#pragma unroll
    for (int t = 0; t < 32; ++t) cs[t * CS_LD + ch] = acc[t];
    __syncthreads();
    const f32x4 g0 = ((const GAS f32x4*)ln_g)[2 * lane], g1 = ((const GAS f32x4*)ln_g)[2 * lane + 1], b0 = ((const GAS f32x4*)ln_b)[2 * lane], b1 = ((const GAS f32x4*)ln_b)[2 * lane + 1];
#pragma unroll
    for (int tt = 0; tt < 4; ++tt) { const int t = wave * 4 + tt;
        f32x4 x0 = *(const LAS f32x4*)(cs + t * CS_LD + 8 * lane), x1 = *(const LAS f32x4*)(cs + t * CS_LD + 8 * lane + 4);
        const float mean = wave_sum((x0.x + x0.y) + (x0.z + x0.w) + (x1.x + x1.y) + (x1.z + x1.w)) * (1.f / DC);
        x0 = x0 - mean; x1 = x1 - mean;
        const float var = wave_sum((x0.x * x0.x + x0.y * x0.y) + (x0.z * x0.z + x0.w * x0.w) + (x1.x * x1.x + x1.y * x1.y) + (x1.z * x1.z + x1.w * x1.w)) * (1.f / DC);
        const float rstd = 1.f / sqrtf(var + EPS);
        x0 = x0 * rstd * g0 + b0; x1 = x1 * rstd * g1 + b1;
        v4u o; o.x = pk2(x0.x * sigmoidf_(x0.x), x0.y * sigmoidf_(x0.y)); o.y = pk2(x0.z * sigmoidf_(x0.z), x0.w * sigmoidf_(x0.w));
        o.z = pk2(x1.x * sigmoidf_(x1.x), x1.y * sigmoidf_(x1.y)); o.w = pk2(x1.z * sigmoidf_(x1.z), x1.w * sigmoidf_(x1.w));
        *(GAS v4u*)(MIX + (rb + T0 + t) * D + 8 * lane) = o; }
    __syncthreads();
}

constexpr int R_QS = 0, R_KS = 17408, R_KZT = 34816, R_VT = 53248, R_RT = 71680, R_SS = 106496, R_OS = 0;
constexpr int QS_LD = 136, KT_LD = 72, RT_LD = 136, SS_LD = 72, OS_LD = 132;
static_assert(R_SS + 64 * SS_LD * 2 <= RING_BYTES && 64 * OS_LD * 4 <= R_KZT, "retention LDS map");
struct RetCtx { const bf16* P; size_t row0; int pos0, C, h; float lg; };

template <bool WITH_Q>
__device__ __forceinline__ void ret_stage(LAS unsigned char* lds, const RetCtx& c, int tid) {
    const int j = tid >> 3, cc = tid & 7; const bool valid = j < c.C;
    float kf1[8], kf2[8], qf1[8], qf2[8]; v4u v1, v2;
    {
        const GAS bf16* prow = (const GAS bf16*)(c.P + (c.row0 + (valid ? j : 0)) * DIN) + c.h * HD + 8 * cc;
        const v4u k1 = *(const GAS v4u*)(prow + 1536), k2 = *(const GAS v4u*)(prow + 1536 + 64); v1 = *(const GAS v4u*)(prow + 2048); v2 = *(const GAS v4u*)(prow + 2048 + 64);
#pragma unroll
        for (int i = 0; i < 4; ++i) { kf1[2 * i] = bf_lo(k1[i]); kf1[2 * i + 1] = bf_hi(k1[i]); kf2[2 * i] = bf_lo(k2[i]); kf2[2 * i + 1] = bf_hi(k2[i]); }
        if (WITH_Q) { const v4u q1 = *(const GAS v4u*)(prow + 1024), q2 = *(const GAS v4u*)(prow + 1024 + 64);
#pragma unroll
            for (int i = 0; i < 4; ++i) { qf1[2 * i] = bf_lo(q1[i]); qf1[2 * i + 1] = bf_hi(q1[i]); qf2[2 * i] = bf_lo(q2[i]); qf2[2 * i + 1] = bf_hi(q2[i]); } }
    }
    if (!valid) { v1 = v2 = (v4u){0u, 0u, 0u, 0u};
#pragma unroll
        for (int i = 0; i < 8; ++i) { kf1[i] = kf2[i] = 0.f; if (WITH_Q) { qf1[i] = qf2[i] = 0.f; } } }
    float cs[8], sn[8]; const float pos = (float)(c.pos0 + j);
#pragma unroll
    for (int i = 0; i < 8; ++i) { const float inv = exp2f((float)(8 * cc + i) * (-13.287712379549449f / 64.0f)); const float ang = pos * inv;
        const float n = rintf(ang * 0.15915494309189535f); float r = fmaf(-n, 6.2831854820251465f, ang); r = fmaf(-n, -1.7484555e-07f, r);
        const float rev = r * 0.15915494309189535f; cs[i] = __builtin_amdgcn_cosf(rev); sn[i] = __builtin_amdgcn_sinf(rev); }
    const float z = valid ? __expf(c.lg * (float)(c.C - 1 - j)) : 0.f;
    const float KS = 0.08838834764831845f;
    float r1[8], r2[8];
#pragma unroll
    for (int i = 0; i < 8; ++i) { r1[i] = (kf1[i] * cs[i] - kf2[i] * sn[i]) * KS; r2[i] = (kf2[i] * cs[i] + kf1[i] * sn[i]) * KS; }
    LAS bf16* KzT = (LAS bf16*)(lds + R_KZT); LAS bf16* VT = (LAS bf16*)(lds + R_VT);
#pragma unroll
    for (int i = 0; i < 8; ++i) { KzT[(8 * cc + i) * KT_LD + j] = (bf16)f2bf(r1[i] * z); KzT[(64 + 8 * cc + i) * KT_LD + j] = (bf16)f2bf(r2[i] * z); }
#pragma unroll
    for (int i = 0; i < 4; ++i) { VT[(8 * cc + 2 * i) * KT_LD + j] = (bf16)(v1[i] & 0xffffu); VT[(8 * cc + 2 * i + 1) * KT_LD + j] = (bf16)(v1[i] >> 16);
                                  VT[(64 + 8 * cc + 2 * i) * KT_LD + j] = (bf16)(v2[i] & 0xffffu); VT[(64 + 8 * cc + 2 * i + 1) * KT_LD + j] = (bf16)(v2[i] >> 16); }
    if (WITH_Q) {
        LAS bf16* Ks = (LAS bf16*)(lds + R_KS); LAS bf16* Qs = (LAS bf16*)(lds + R_QS);
        v4u o; o.x = pk2(r1[0], r1[1]); o.y = pk2(r1[2], r1[3]); o.z = pk2(r1[4], r1[5]); o.w = pk2(r1[6], r1[7]); *(LAS v4u*)(Ks + j * QS_LD + 8 * cc) = o;
        o.x = pk2(r2[0], r2[1]); o.y = pk2(r2[2], r2[3]); o.z = pk2(r2[4], r2[5]); o.w = pk2(r2[6], r2[7]); *(LAS v4u*)(Ks + j * QS_LD + 64 + 8 * cc) = o;
#pragma unroll
        for (int i = 0; i < 8; ++i) { r1[i] = qf1[i] * cs[i] - qf2[i] * sn[i]; r2[i] = qf2[i] * cs[i] + qf1[i] * sn[i]; }
        o.x = pk2(r1[0], r1[1]); o.y = pk2(r1[2], r1[3]); o.z = pk2(r1[4], r1[5]); o.w = pk2(r1[6], r1[7]); *(LAS v4u*)(Qs + j * QS_LD + 8 * cc) = o;
        o.x = pk2(r2[0], r2[1]); o.y = pk2(r2[2], r2[3]); o.z = pk2(r2[4], r2[5]); o.w = pk2(r2[6], r2[7]); *(LAS v4u*)(Qs + j * QS_LD + 64 + 8 * cc) = o;
    }
}
#define MFMA16(a, b, c) __builtin_amdgcn_mfma_f32_16x16x32_bf16((a), (b), (c), 0, 0, 0)
__device__ __forceinline__ void ret_update(LAS unsigned char* lds, f32x4 (&racc)[8], float gch, int w, int fr, int fq) {
    const LAS bf16* KzT = (const LAS bf16*)(lds + R_KZT); const LAS bf16* VT = (const LAS bf16*)(lds + R_VT);
#pragma unroll
    for (int vb = 0; vb < 8; ++vb) racc[vb] = racc[vb] * gch;
#pragma unroll
    for (int ks = 0; ks < 2; ++ks) { const bf16x8 a = *(const LAS bf16x8*)(KzT + (16 * w + fr) * KT_LD + 32 * ks + 8 * fq);
#pragma unroll
        for (int vb = 0; vb < 8; ++vb) { const bf16x8 bb = *(const LAS bf16x8*)(VT + (16 * vb + fr) * KT_LD + 32 * ks + 8 * fq); racc[vb] = MFMA16(a, bb, racc[vb]); } }
}
__device__ __forceinline__ void ret_write_rt(LAS unsigned char* lds, const f32x4 (&racc)[8], int w, int fr, int fq) {
    LAS bf16* RT = (LAS bf16*)(lds + R_RT);
#pragma unroll
    for (int vb = 0; vb < 8; ++vb) { u32x2 o; o.x = pk2(racc[vb][0], racc[vb][1]); o.y = pk2(racc[vb][2], racc[vb][3]); *(LAS u32x2*)(RT + (16 * vb + fr) * RT_LD + 16 * w + 4 * fq) = o; }
}
__device__ __forceinline__ void ret_pass_a(LAS unsigned char* lds, const bf16* P, int unit, float* AGG, int tid, int lane, int wave) {
    const int b = unit >> 7, h = (unit >> 5) & 3, grp = unit & 31, fr = lane & 15, fq = lane >> 4;
    const float lg = log1pf(-exp2f(-5.0f - (float)h)), gch = __expf(lg * 64.f);
    f32x4 racc[8];
#pragma unroll
    for (int vb = 0; vb < 8; ++vb) racc[vb] = (f32x4){0.f, 0.f, 0.f, 0.f};
    for (int ci = 0; ci < 4; ++ci) {
        RetCtx c{P, (size_t)b * TP + (size_t)(grp * 4 + ci) * 64, (grp * 4 + ci) * 64, 64, h, lg};
        ret_stage<false>(lds, c, tid);
        __syncthreads();
        ret_update(lds, racc, gch, wave, fr, fq);
        __syncthreads();
    }
    float* o = AGG + (size_t)unit * (HD * HD);
#pragma unroll
    for (int vb = 0; vb < 8; ++vb)
#pragma unroll
        for (int r = 0; r < 4; ++r) ((GAS float*)o)[(16 * wave + 4 * fq + r) * HD + 16 * vb + fr] = racc[vb][r];
}
__device__ __forceinline__ void ret_pass_b(LAS unsigned char* lds, const bf16* P, int unit, bool smp, const float* AGG, const float* state_ret, const float* gn_g, bf16* MIX, float* out,
                                           int tid, int lane, int wave) {
    const int b = smp ? unit >> 2 : unit >> 7, h = smp ? unit & 3 : (unit >> 5) & 3, grp = smp ? 0 : unit & 31, fr = lane & 15, fq = lane >> 4, w = wave;
    const int C = smp ? TS : 64, nch = smp ? 1 : 4;
    const float lg = log1pf(-exp2f(-5.0f - (float)h)), gch = __expf(lg * (float)C);
    f32x4 racc[8];
    if (smp) { const GAS float* s = (const GAS float*)state_ret + (size_t)(b * NH + h) * (HD * HD);
#pragma unroll
        for (int vb = 0; vb < 8; ++vb)
#pragma unroll
            for (int r = 0; r < 4; ++r) racc[vb][r] = s[(16 * w + 4 * fq + r) * HD + 16 * vb + fr];
    } else {
        const float g4 = __expf(lg * 256.f);
#pragma unroll
        for (int vb = 0; vb < 8; ++vb) racc[vb] = (f32x4){0.f, 0.f, 0.f, 0.f};
        for (int gp = 0; gp < grp; ++gp) { const GAS float* s = (const GAS float*)AGG + (size_t)((unit & ~31) + gp) * (HD * HD);
#pragma unroll
            for (int vb = 0; vb < 8; ++vb)
#pragma unroll
                for (int r = 0; r < 4; ++r) racc[vb][r] = racc[vb][r] * g4 + s[(16 * w + 4 * fq + r) * HD + 16 * vb + fr]; }
    }
    ret_write_rt(lds, racc, w, fr, fq);
    const LAS bf16* Qs = (const LAS bf16*)(lds + R_QS); const LAS bf16* Ks = (const LAS bf16*)(lds + R_KS); const LAS bf16* VT = (const LAS bf16*)(lds + R_VT);
    const LAS bf16* RT = (const LAS bf16*)(lds + R_RT); LAS bf16* Ss = (LAS bf16*)(lds + R_SS); LAS float* Os = (LAS float*)(lds + R_OS);
    for (int ci = 0; ci < nch; ++ci) {
        const size_t row0 = smp ? (size_t)MP + b * TS : (size_t)b * TP + (size_t)(grp * 4 + ci) * 64;
        RetCtx c{P, row0, smp ? PAST : (grp * 4 + ci) * 64, C, h, lg};
        ret_stage<true>(lds, c, tid);
        __syncthreads();
        {
            const int ib = w >> 1, jb0 = 2 * (w & 1);
            f32x4 sacc[2] = {(f32x4){0.f, 0.f, 0.f, 0.f}, (f32x4){0.f, 0.f, 0.f, 0.f}};
#pragma unroll
            for (int ks = 0; ks < 4; ++ks) { const bf16x8 a = *(const LAS bf16x8*)(Qs + (16 * ib + fr) * QS_LD + 32 * ks + 8 * fq);
#pragma unroll
                for (int t = 0; t < 2; ++t) { const bf16x8 bb = *(const LAS bf16x8*)(Ks + (16 * (jb0 + t) + fr) * QS_LD + 32 * ks + 8 * fq); sacc[t] = MFMA16(a, bb, sacc[t]); } }
#pragma unroll
            for (int t = 0; t < 2; ++t) { const int j = 16 * (jb0 + t) + fr;
#pragma unroll
                for (int r = 0; r < 4; ++r) { const int i = 16 * ib + 4 * fq + r; const float v = (i >= j) ? sacc[t][r] * __expf(lg * (float)(i - j)) : 0.f; Ss[i * SS_LD + j] = (bf16)f2bf(v); } }
        }
        __syncthreads();
        f32x4 oacc[4];
#pragma unroll
        for (int ib = 0; ib < 4; ++ib) oacc[ib] = (f32x4){0.f, 0.f, 0.f, 0.f};
#pragma unroll
        for (int ks = 0; ks < 4; ++ks) { const bf16x8 bb = *(const LAS bf16x8*)(RT + (16 * w + fr) * RT_LD + 32 * ks + 8 * fq);
#pragma unroll
            for (int ib = 0; ib < 4; ++ib) { const bf16x8 a = *(const LAS bf16x8*)(Qs + (16 * ib + fr) * QS_LD + 32 * ks + 8 * fq); oacc[ib] = MFMA16(a, bb, oacc[ib]); } }
#pragma unroll
        for (int ib = 0; ib < 4; ++ib)
#pragma unroll
            for (int r = 0; r < 4; ++r) oacc[ib][r] *= __expf(lg * (float)(16 * ib + 4 * fq + r + 1));
#pragma unroll
        for (int ks = 0; ks < 2; ++ks) { const bf16x8 bb = *(const LAS bf16x8*)(VT + (16 * w + fr) * KT_LD + 32 * ks + 8 * fq);
#pragma unroll
            for (int ib = 0; ib < 4; ++ib) { const bf16x8 a = *(const LAS bf16x8*)(Ss + (16 * ib + fr) * SS_LD + 32 * ks + 8 * fq); oacc[ib] = MFMA16(a, bb, oacc[ib]); } }
        __syncthreads();
#pragma unroll
        for (int ib = 0; ib < 4; ++ib)
#pragma unroll
            for (int r = 0; r < 4; ++r) Os[(16 * ib + 4 * fq + r) * OS_LD + 16 * w + fr] = oacc[ib][r];
        ret_update(lds, racc, gch, w, fr, fq);
        ret_write_rt(lds, racc, w, fr, fq);
        __syncthreads();
        {
            const f32x2 gg = *(const GAS f32x2*)(gn_g + h * HD + 2 * lane);
#pragma unroll
            for (int tt = 0; tt < 8; ++tt) { const int i = 8 * w + tt;
                if (i < C) {
                    f32x2 x = *(const LAS f32x2*)(Os + i * OS_LD + 2 * lane);
                    const float mu = wave_sum(x.x + x.y) * (1.f / HD); x = x - mu;
                    const float var = wave_sum(x.x * x.x + x.y * x.y) * (1.f / HD), rstd = 1.f / sqrtf(var + EPS);
                    const unsigned gw = *(const GAS unsigned*)(P + (row0 + i) * DIN + 2560 + h * HD + 2 * lane);
                    const float g0 = bf_lo(gw), g1 = bf_hi(gw);
                    *(GAS unsigned*)(MIX + (row0 + i) * D + DC + h * HD + 2 * lane) = pk2(x.x * rstd * gg.x * (g0 * sigmoidf_(g0)), x.y * rstd * gg.y * (g1 * sigmoidf_(g1)));
                } }
        }
        __syncthreads();
    }
    if (smp || grp == 31) {
        float* o = out + (smp ? O_RS : O_RP) + (size_t)(b * NH + h) * (HD * HD);
#pragma unroll
        for (int vb = 0; vb < 8; ++vb)
#pragma unroll
            for (int r = 0; r < 4; ++r) ((GAS float*)o)[(16 * w + 4 * fq + r) * HD + 16 * vb + fr] = racc[vb][r];
    }
}

struct Args { const float* in[23]; float* out; unsigned char* ws; int ph_lo, ph_hi, li, pad; };
#define CAS __attribute__((address_space(4)))
__device__ __forceinline__ const CAS unsigned char* karg_base() { const CAS unsigned char* kp = (const CAS unsigned char*)__builtin_amdgcn_kernarg_segment_ptr(); asm volatile("" : "+s"(kp)); return kp; }
__device__ __forceinline__ const float* karg_in(int i) { return *(const float* const CAS*)(karg_base() + 8 * i); }
__device__ __forceinline__ float* karg_out() { return *(float* const CAS*)(karg_base() + 8 * 23); }
__device__ __forceinline__ unsigned char* karg_ws() { return *(unsigned char* const CAS*)(karg_base() + 8 * 24); }
__device__ __forceinline__ int karg_lo() { return *(const CAS int*)(karg_base() + 200); }
__device__ __forceinline__ int karg_hi() { return *(const CAS int*)(karg_base() + 204); }
#define PHASE_IDS() int tid = threadIdx.x; asm volatile("" : "+v"(tid)); const int lane = tid & 63, wave = __builtin_amdgcn_readfirstlane(tid >> 6); \
    const int G = gridDim.x, bx = blockIdx.x; (void)lane; (void)wave; (void)G; (void)bx
#define PHASE_GW() const int vcu = (G % 8 == 0) ? (bx % 8) * (G / 8) + bx / 8 : bx; const int gw = vcu * NWAVES + wave, NGW = G * NWAVES

__device__ __forceinline__ void ph_prologue(LAS unsigned char* lds) {
    PHASE_IDS(); PHASE_GW();
    unsigned char* ws = karg_ws();
    LAS float* scr = (LAS float*)(lds + RING_OFF + wave * 16384);
    constexpr int I_GU = (D / 64) * (FF / 32), I_DN = (FF / 64) * (D / 32), I_IN = (D / 64) * (DIN / 32), I_OUT = (D / 64) * (D / 32);
    constexpr int NITEMS = 4 * I_GU + 2 * I_DN + I_IN + I_OUT;
    for (int it = gw; it < NITEMS; it += NGW) {
        int r = it;
        if (r < I_GU) { p0_transpose_item(karg_in(5), D, FF, (bf16*)(ws + WS_WGU1), 1, scr, r, lane); continue; } r -= I_GU;
        if (r < I_GU) { p0_transpose_item(karg_in(6), D, FF, (bf16*)(ws + WS_WGU1), 2, scr, r, lane); continue; } r -= I_GU;
        if (r < I_DN) { p0_transpose_item(karg_in(7), FF, D, (bf16*)(ws + WS_WD1), 0, scr, r, lane); continue; } r -= I_DN;
        if (r < I_IN) { p0_transpose_item(karg_in(10), D, DIN, (bf16*)(ws + WS_WIN), 0, scr, r, lane); continue; } r -= I_IN;
        if (r < I_OUT) { p0_transpose_item(karg_in(16), D, D, (bf16*)(ws + WS_WOUT), 0, scr, r, lane); continue; } r -= I_OUT;
        if (r < I_GU) { p0_transpose_item(karg_in(19), D, FF, (bf16*)(ws + WS_WGU2), 1, scr, r, lane); continue; } r -= I_GU;
        if (r < I_GU) { p0_transpose_item(karg_in(20), D, FF, (bf16*)(ws + WS_WGU2), 2, scr, r, lane); continue; } r -= I_GU;
        p0_transpose_item(karg_in(21), FF, D, (bf16*)(ws + WS_WD2), 0, scr, r, lane);
    }
    const float* xp = karg_in(0); const float* xs = karg_in(1); const float* g = karg_in(4); bf16* Hb = (bf16*)(ws + WS_H);
    for (int m = gw; m < M; m += NGW) rms_row_to_bf16(m < MP ? xp + (size_t)m * D : xs + (size_t)(m - MP) * D, g, Hb + (size_t)m * D, lane);
}
template <int IT> __device__ __forceinline__ void ph_gateup(LAS unsigned char* lds) {
    unsigned char* ws = karg_ws();
    pg8::Gemm g{(const bf16*)(ws + WS_H), (const bf16*)(ws + (IT ? WS_WGU2 : WS_WGU1)), M, 2 * FF, D}; pg8::StaticOrder S; S.init(MP, 2 * FF, D, (int)gridDim.x, (int)blockIdx.x); S.extra(MP / 256, 1);
    pg8::EpiSwiglu E{(bf16*)(ws + WS_ACT), FF};
    pg8::gemm_phase<pg8::EpiSwiglu, pg8::StaticOrder, PG8_ALIGN, PG8_SP2>(lds + RING_OFF, g, S, E);
}
template <int IT> __device__ __forceinline__ void ph_down(LAS unsigned char* lds) {
    unsigned char* ws = karg_ws();
    pg8::Gemm g{(const bf16*)(ws + WS_ACT), (const bf16*)(ws + (IT ? WS_WD2 : WS_WD1)), M, D, FF}; pg8::StaticOrder S; S.init(MP, D, FF, (int)gridDim.x, (int)blockIdx.x); S.extra(MP / 256, NKS_DOWN);
    pg8::EpiF32 E{(float*)(ws + WS_F), D, (float*)(ws + WS_SLAB)};
    pg8::gemm_phase<pg8::EpiF32, pg8::StaticOrder, PG8_ALIGN, PG8_SP2>(lds + RING_OFF, g, S, E);
}
template <int WHICH> __device__ __forceinline__ void ph_norm() {
    PHASE_IDS(); PHASE_GW();
    unsigned char* ws = karg_ws(); float* Y = karg_out() + O_Y; const float* Fb = (const float*)(ws + WS_F); bf16* Hb = (bf16*)(ws + WS_H);
    const float* gpost = karg_in(WHICH == 0 ? 8 : (WHICH == 1 ? 17 : 22)); const float* gnext = WHICH == 2 ? nullptr : karg_in(WHICH == 0 ? 9 : 18);
    const float* xp = karg_in(0); const float* xs = karg_in(1);
    for (int m = gw; m < M; m += NGW) {
        const float* xr = WHICH == 0 ? (m < MP ? xp + (size_t)m * D : xs + (size_t)(m - MP) * D) : (const float*)(Y + (size_t)m * D);
        const bool smp = m >= MP; const float* fr = smp ? (const float*)(ws + WS_SLAB) + (size_t)(m - MP) * D : Fb + (size_t)m * D;
        norm_row(fr, smp ? (WHICH == 1 ? NKS_OUT : NKS_DOWN) : 1, (size_t)256 * D, xr, WHICH == 1 ? 1.0f : 0.5f, gpost, Y + (size_t)m * D, gnext, Hb + (size_t)m * D, lane);
    }
}
__device__ __forceinline__ void ph_win(LAS unsigned char* lds) {
    unsigned char* ws = karg_ws();
    pg8::Gemm g{(const bf16*)(ws + WS_H), (const bf16*)(ws + WS_WIN), M, DIN, D}; pg8::StaticOrder S; S.init(MP, DIN, D, (int)gridDim.x, (int)blockIdx.x); S.extra(MP / 256, NKS_IN);
    pg8::EpiBf16 E{(bf16*)(ws + WS_ACT), DIN, (float*)(ws + WS_SLAB)};
    pg8::gemm_phase<pg8::EpiBf16, pg8::StaticOrder, PG8_ALIGN, PG8_SP2>(lds + RING_OFF, g, S, E);
}
__device__ __forceinline__ void ph_wout(LAS unsigned char* lds) {
    unsigned char* ws = karg_ws();
    pg8::Gemm g{(const bf16*)(ws + WS_H), (const bf16*)(ws + WS_WOUT), M, D, D}; pg8::StaticOrder S; S.init(MP, D, D, (int)gridDim.x, (int)blockIdx.x); S.extra(MP / 256, NKS_OUT);
    pg8::EpiF32 E{(float*)(ws + WS_F), D, (float*)(ws + WS_SLAB)};
    pg8::gemm_phase<pg8::EpiF32, pg8::StaticOrder, PG8_ALIGN, PG8_SP2>(lds + RING_OFF, g, S, E);
}
__device__ __forceinline__ void ph_mix1(LAS unsigned char* lds) {
    PHASE_IDS();
    unsigned char* ws = karg_ws(); const bf16* Pb = (const bf16*)(ws + WS_ACT);
    for (int r = bx; r < MS; r += G) {
        const GAS float* sl = (const GAS float*)(ws + WS_SLAB) + (size_t)r * DIN; GAS bf16* o = (GAS bf16*)(ws + WS_ACT) + (size_t)(MP + r) * DIN;
#pragma unroll
        for (int k = 0; k < 3; ++k) { const int col = 2 * tid + 1024 * k; f32x2 a = *(const GAS f32x2*)(sl + col);
#pragma unroll
            for (int q = 1; q < NKS_IN; ++q) a = a + *(const GAS f32x2*)(sl + (size_t)q * 256 * DIN + col);
            *(GAS unsigned*)(o + col) = pk2(a.x, a.y); }
    }
    if ((bx & 31) != 31) ret_pass_a(lds, Pb, bx, (float*)(ws + WS_F), tid, lane, wave);
    for (int cu = bx; cu < 512; cu += G) conv_unit(lds, cu, Pb, karg_in(2), karg_in(11), karg_in(12), karg_in(13), karg_in(14), (bf16*)(ws + WS_H), karg_out(), tid, lane, wave);
}
__device__ __forceinline__ void ph_mix2(LAS unsigned char* lds) {
    PHASE_IDS();
    unsigned char* ws = karg_ws();
#pragma unroll 1
    for (int k = 0; k < 2; ++k) {
        if (k == 1 && bx >= 32) break;
        ret_pass_b(lds, (const bf16*)(ws + WS_ACT), bx, k == 1, (const float*)(ws + WS_F), karg_in(3), karg_in(15), (bf16*)(ws + WS_H), karg_out(), tid, lane, wave);
    }
    if (bx >= 32 && bx < 40) conv_unit(lds, 512 + bx - 32, (const bf16*)(ws + WS_ACT), karg_in(2), karg_in(11), karg_in(12), karg_in(13), karg_in(14), (bf16*)(ws + WS_H), karg_out(), tid, lane, wave);
}

__global__ void __launch_bounds__(NWAVES * 64, 2) mk_fwd(Args args) {
    extern __shared__ __attribute__((aligned(16))) unsigned char lds_raw[];
    LAS unsigned char* lds = (LAS unsigned char*)lds_raw;
    volatile LAS unsigned* MISC = (volatile LAS unsigned*)(lds + MISC_OFF);
    for (int u = threadIdx.x; u < (LDS_BYTES - LDSCTL_OFF) / 4; u += NWAVES * 64) ((LAS unsigned*)(lds + LDSCTL_OFF))[u] = 0u;
    __syncthreads();
    gu32* ctl = (gu32*)(karg_ws() + WS_CTL);
    XcdBarrier bar; bar.bar = (unsigned*)(ctl + CW_BAR); bar.x = 0; bar.st = nullptr;
    if (N_LAUNCHES != PER_PHASE) bar = xcd_barrier_post((unsigned*)(ctl + CW_BAR), MISC + 8);
#define IN(k) (karg_lo() <= (k) && (k) < karg_hi())
#define SEAM(k) do { if (N_LAUNCHES != PER_PHASE && IN(k) && IN((k) + 1)) xcd_barrier(bar); } while (0)
    if (IN(0)) { ph_prologue(lds); SEAM(0); }
    if (IN(1)) { ph_gateup<0>(lds); SEAM(1); }
    if (IN(2)) { ph_down<0>(lds); SEAM(2); }
    if (IN(3)) { ph_norm<0>(); SEAM(3); }
    if (IN(4)) { ph_win(lds); SEAM(4); }
    if (IN(5)) { ph_mix1(lds); SEAM(5); }
    if (IN(6)) { ph_mix2(lds); SEAM(6); }
    if (IN(7)) { ph_wout(lds); SEAM(7); }
    if (IN(8)) { ph_norm<1>(); SEAM(8); }
    if (IN(9)) { ph_gateup<1>(lds); SEAM(9); }
    if (IN(10)) { ph_down<1>(lds); SEAM(10); }
    if (IN(11)) { ph_norm<2>(); }
#undef IN
#undef SEAM
    (void)args;
}

extern "C" void kernel_launch(void* const* d_in, const int* in_sizes, int n_in, void* d_out, int out_size, void* d_ws, size_t ws_size, hipStream_t stream) {
    static int grid = 0;
    if (grid == 0) {
        if (n_in != 23 || in_sizes[0] != MP * D || out_size != (int)O_END || ws_size < WS_END) { fprintf(stderr, "kernel_launch: unexpected shapes: n_in %d in0 %d out %d ws %zu; nothing launched\n", n_in, n_in > 0 ? in_sizes[0] : -1, out_size, ws_size); grid = -1; return; }
        int dev = 0, cus = 0, per_cu = 0;
        if (hipGetDevice(&dev) != hipSuccess || hipDeviceGetAttribute(&cus, hipDeviceAttributeMultiprocessorCount, dev) != hipSuccess) { fprintf(stderr, "kernel_launch: device query failed\n"); grid = -1; return; }
        if (hipFuncSetAttribute((const void*)mk_fwd, hipFuncAttributeMaxDynamicSharedMemorySize, LDS_BYTES) != hipSuccess) { fprintf(stderr, "kernel_launch: hipFuncSetAttribute failed\n"); grid = -1; return; }
        if (hipOccupancyMaxActiveBlocksPerMultiprocessor(&per_cu, (const void*)mk_fwd, NWAVES * 64, LDS_BYTES) != hipSuccess || per_cu < 1)
            fprintf(stderr, "kernel_launch: note: occupancy query reports %d workgroups per CU\n", per_cu);
        (void)hipGetLastError();
        grid = cus;
        if (grid != 256) fprintf(stderr, "kernel_launch: %d CUs; this kernel is laid out for 256\n", grid);
    }
    if (grid < 0) return;
    if (hipMemsetAsync((char*)d_ws + WS_CTL, 0, CTL_ZERO_BYTES, stream) != hipSuccess) { fprintf(stderr, "kernel_launch: hipMemsetAsync failed\n"); return; }
    Args a{};
    for (int i = 0; i < 23; ++i) a.in[i] = (const float*)d_in[i];
    a.out = (float*)d_out; a.ws = (unsigned char*)d_ws;
    for (int li = 0; li < N_LAUNCHES; ++li) {
        a.ph_lo = (N_LAUNCHES == PER_PHASE) ? li : 0; a.ph_hi = (N_LAUNCHES == PER_PHASE) ? li + 1 : PER_PHASE; a.li = li;
        hipLaunchKernelGGL(mk_fwd, dim3(grid), dim3(NWAVES * 64), LDS_BYTES, stream, a);
        const hipError_t le = hipPeekAtLastError();
        if (le != hipSuccess) { fprintf(stderr, "kernel_launch: launch %d failed: %s\n", li, hipGetErrorName(le)); break; }
    }
}
```

```cpp
#include <hip/hip_runtime.h>
#include <cstdio>
#include <cstdint>
namespace pg8 {
#define PG8_LAS __attribute__((address_space(3)))
typedef unsigned short bf16_t;
typedef short bf16x8 __attribute__((ext_vector_type(8)));
typedef float f32x4 __attribute__((ext_vector_type(4)));
typedef unsigned u32x4 __attribute__((ext_vector_type(4)));
constexpr int BM = 256, BK = 64, HALF = 128, HTB = HALF * BK * 2  , STAGE_BYTES = 8 * HTB, NXCD = 8, WGM = 8;

__host__ __device__ __forceinline__ int lds_byte(int r, int c) { const int st = (r >> 4) * 2 + (c >> 5), rr = r & 15, cc = c & 31, ob = rr * 64 + cc * 2; return st * 1024 + (ob ^ (((ob >> 9) & 1) << 5)); }
__host__ __device__ __forceinline__ void stage_rc(int b, int& R, int& C) { const int st = b / 1024, sb = b % 1024, swz = sb ^ (((sb >> 9) & 1) << 5); R = (st >> 1) * 16 + swz / 64; C = (st & 1) * 32 + (swz % 64) / 2; }
__host__ __device__ __forceinline__ int perm32(int rho) { const int n = rho >> 4, i = rho & 15; return 8 * (i >> 2) + 4 * n + (i & 3); }

struct Unit { int pm, pn, koff, nt, slab; };
struct Gemm { const bf16_t* A; const bf16_t* Bt; int M, N, K; };

struct StaticOrder {
    int nM, nN, nwg, G, c, ntF;
    int nS, nks, ntS, pmS;
    __host__ __device__ void init(int M, int N, int K, int G_, int c_) { nM = M / BM; nN = N / BM; nwg = nM * nN; G = G_; c = c_; ntF = K / BK; nS = 0; nks = 1; ntS = ntF; pmS = 0; }
    __host__ __device__ void extra(int pm, int nks_) { pmS = pm; nks = nks_; ntS = ntF / nks_; nS = nN * nks_; }
    __host__ __device__ bool next(int i, Unit& u) const {
        const long L = (long)i * G + c; if (L >= nwg + nS) return false;
        if (L >= nwg) { const int s = (int)L - nwg, ks = s % nks; u.pm = pmS; u.pn = s / nks; u.koff = ks * ntS * BK; u.nt = ntS; u.slab = nks > 1 ? ks : -1; return true; }
        int wgid = (int)L; { const int q = nwg / NXCD, r = nwg % NXCD, xcd = wgid % NXCD, off = wgid / NXCD; wgid = (xcd < r ? xcd * (q + 1) : r * (q + 1) + (xcd - r) * q) + off; }
        const int nig = WGM * nN, gid = wgid / nig, fm = gid * WGM, gsz = (nM - fm) < WGM ? (nM - fm) : WGM;
        u.pm = fm + ((wgid % nig) % gsz); u.pn = (wgid % nig) / gsz; u.koff = 0; u.nt = ntF; u.slab = -1; return true;
    }
    __device__ __forceinline__ void a_ready(const Unit&) const {}
    __device__ __forceinline__ void done(const Unit&) const {}
};

__device__ __forceinline__ unsigned cvt_pk_bf16(float lo, float hi) { unsigned r; asm volatile("v_cvt_pk_bf16_f32 %0, %1, %2" : "=v"(r) : "v"(lo), "v"(hi)); return r; }
__device__ __forceinline__ float fast_sigmoid(float x) { return __builtin_amdgcn_rcpf(1.0f + __builtin_amdgcn_exp2f(x * -1.44269504089f)); }
__device__ __forceinline__ float fast_silu(float x) { return x * fast_sigmoid(x); }

struct EpiF32 {
    static constexpr bool PERM = false, AFTER_DRAIN = false;
    float* C; int ldc; float* slab;
    __device__ __forceinline__ void operator()(const f32x4 (&acc)[2][2][4][2], const Unit& u, int wr, int wc, int fr, int fq) const {
        const int row0 = wr * 64 + fr, col0 = u.pn * BM + wc * 32 + 4 * fq;
        float* base = u.slab >= 0 ? slab + (size_t)u.slab * BM * ldc : C + (size_t)u.pm * BM * ldc;
#pragma unroll
        for (int ai = 0; ai < 2; ++ai)
#pragma unroll
            for (int m = 0; m < 4; ++m) { float* rowp = base + (size_t)(row0 + ai * HALF + m * 16) * ldc + col0;
#pragma unroll
                for (int bj = 0; bj < 2; ++bj)
#pragma unroll
                    for (int n = 0; n < 2; ++n) *(f32x4*)(rowp + bj * HALF + n * 16) = acc[ai][bj][m][n]; }
    }
};
struct EpiBf16 {
    static constexpr bool PERM = true, AFTER_DRAIN = false;
    bf16_t* O; int ldc; float* slab;
    __device__ __forceinline__ void operator()(const f32x4 (&acc)[2][2][4][2], const Unit& u, int wr, int wc, int fr, int fq) const {
        const int row0 = wr * 64 + fr, col0 = u.pn * BM + wc * 32 + 8 * fq;
        if (u.slab >= 0) {
            float* base = slab + (size_t)u.slab * BM * ldc;
#pragma unroll
            for (int ai = 0; ai < 2; ++ai)
#pragma unroll
                for (int m = 0; m < 4; ++m) { float* rowp = base + (size_t)(row0 + ai * HALF + m * 16) * ldc + col0;
#pragma unroll
                    for (int bj = 0; bj < 2; ++bj)
#pragma unroll
                        for (int n = 0; n < 2; ++n) *(f32x4*)(rowp + bj * HALF + n * 4) = acc[ai][bj][m][n]; }
            return;
        }
#pragma unroll
        for (int ai = 0; ai < 2; ++ai)
#pragma unroll
            for (int m = 0; m < 4; ++m) { bf16_t* rowp = O + (size_t)(u.pm * BM + row0 + ai * HALF + m * 16) * ldc + col0;
#pragma unroll
                for (int bj = 0; bj < 2; ++bj) { const f32x4 v0 = acc[ai][bj][m][0], v1 = acc[ai][bj][m][1];
                    u32x4 w; w.x = cvt_pk_bf16(v0[0], v0[1]); w.y = cvt_pk_bf16(v0[2], v0[3]); w.z = cvt_pk_bf16(v1[0], v1[1]); w.w = cvt_pk_bf16(v1[2], v1[3]);
                    *(u32x4*)(rowp + bj * HALF) = w; } }
    }
};
struct EpiSwiglu {
    static constexpr bool PERM = true, AFTER_DRAIN = false;
    bf16_t* O; int ldc;
    __device__ __forceinline__ void operator()(const f32x4 (&acc)[2][2][4][2], const Unit& u, int wr, int wc, int fr, int fq) const {
        const int row0 = u.pm * BM + wr * 64 + fr, col0 = u.pn * HALF + wc * 32 + 8 * fq;
#pragma unroll
        for (int ai = 0; ai < 2; ++ai)
#pragma unroll
            for (int m = 0; m < 4; ++m) { bf16_t* rowp = O + (size_t)(row0 + ai * HALF + m * 16) * ldc + col0;
                const f32x4 g0 = acc[ai][0][m][0], g1 = acc[ai][0][m][1], u0 = acc[ai][1][m][0], u1 = acc[ai][1][m][1];
                u32x4 w; w.x = cvt_pk_bf16(fast_silu(g0[0]) * u0[0], fast_silu(g0[1]) * u0[1]); w.y = cvt_pk_bf16(fast_silu(g0[2]) * u0[2], fast_silu(g0[3]) * u0[3]);
                w.z = cvt_pk_bf16(fast_silu(g1[0]) * u1[0], fast_silu(g1[1]) * u1[1]); w.w = cvt_pk_bf16(fast_silu(g1[2]) * u1[2], fast_silu(g1[3]) * u1[3]);
                *(u32x4*)rowp = w; }
    }
};

template <class Epi, class Sched, bool ALIGN_EPI = false, bool SP2 = false>
__device__ __forceinline__ void gemm_phase(PG8_LAS unsigned char* lds, const Gemm g, const Sched& S, const Epi& E) {
    int tid_ = threadIdx.x; asm volatile("" : "+v"(tid_)); const int tid = tid_, wid = __builtin_amdgcn_readfirstlane(tid >> 6), lane = tid & 63, wr = wid >> 2, wc = wid & 3, fr = lane & 15, fq = lane >> 4;
    const int K = g.K;
    unsigned voffA[2], voffB[2];
#pragma unroll
    for (int i = 0; i < 2; ++i) { int R, C; stage_rc(tid * 16 + i * 8192, R, C); const int Rb = Epi::PERM ? ((R & ~31) + perm32(R & 31)) : R;
        voffA[i] = (unsigned)(R * K + C) * 2u; voffB[i] = (unsigned)(Rb * K + C) * 2u; }
    const size_t kstep = (size_t)(BK * 2);
    const size_t hstep = (size_t)HALF * K * 2;
    const size_t tstep = 2 * hstep;
    const unsigned ldsw = (unsigned)wid * 1024u;
    const int aoff = lds_byte(wr * 64 + fr, fq * 8), boff = lds_byte(wc * 32 + fr, fq * 8);
#define PG8_SA(b, h) (((b) * 2 + (h)) * HTB)
#define PG8_SB(b, h) ((4 + (b) * 2 + (h)) * HTB)
#define PG8_STAGE(bufoff, gbase, voff) do { _Pragma("unroll") for (int _i = 0; _i < 2; ++_i) \
        __builtin_amdgcn_global_load_lds((const unsigned*)((const char*)(gbase) + (voff)[_i]), (PG8_LAS unsigned*)(lds + (bufoff) + ldsw + _i * 8192), 16, 0, 0); } while (0)
#define PG8_LDA(dst, b, h) do { _Pragma("unroll") for (int m = 0; m < 4; ++m) _Pragma("unroll") for (int k = 0; k < 2; ++k) dst[m][k] = *(const PG8_LAS bf16x8*)(lds + PG8_SA(b, h) + aoff + m * 2048 + k * 1024); } while (0)
#define PG8_LDB(dst, b, h) do { _Pragma("unroll") for (int n = 0; n < 2; ++n) _Pragma("unroll") for (int k = 0; k < 2; ++k) dst[n][k] = *(const PG8_LAS bf16x8*)(lds + PG8_SB(b, h) + boff + n * 2048 + k * 1024); } while (0)
#define PG8_MMA(ai, bj, At, Bt) do { __builtin_amdgcn_s_setprio(1); _Pragma("unroll") for (int m = 0; m < 4; ++m) _Pragma("unroll") for (int n = 0; n < 2; ++n) _Pragma("unroll") for (int k = 0; k < 2; ++k) \
        acc[ai][bj][m][n] = __builtin_amdgcn_mfma_f32_16x16x32_bf16(Bt[n][k], At[m][k], acc[ai][bj][m][n], 0, 0, 0); __builtin_amdgcn_s_setprio(0); } while (0)
#define PG8_WAIT_V(n) asm volatile("s_waitcnt vmcnt(" #n ")" ::: "memory")
#define PG8_WAIT_L(n) asm volatile("s_waitcnt lgkmcnt(" #n ")" ::: "memory")
#define PG8_BAR __builtin_amdgcn_s_barrier()
#define PG8_SCHED __builtin_amdgcn_sched_barrier(0)
    Unit cur, nxt; int ui = 0;
    if (!S.next(0, cur)) return;
    f32x4 acc[2][2][4][2];
#pragma unroll
    for (int a = 0; a < 2; ++a)
#pragma unroll
        for (int b = 0; b < 2; ++b)
#pragma unroll
            for (int m = 0; m < 4; ++m)
#pragma unroll
                for (int n = 0; n < 2; ++n) acc[a][b][m][n] = (f32x4){0.f, 0.f, 0.f, 0.f};
    bf16x8 At[4][2], B0[2][2], B1[2][2];
    const char* cA = (const char*)g.A + (size_t)cur.pm * tstep + (size_t)cur.koff * 2; const char* cB = (const char*)g.Bt + (size_t)cur.pn * tstep + (size_t)cur.koff * 2;
    S.a_ready(cur);
    if constexpr (SP2) {
        PG8_STAGE(PG8_SB(0, 0), cB, voffB); PG8_STAGE(PG8_SB(0, 1), cB + hstep, voffB); PG8_STAGE(PG8_SA(0, 0), cA, voffA); PG8_STAGE(PG8_SA(0, 1), cA + hstep, voffA);
        if (wr == 1) PG8_BAR;
        PG8_WAIT_V(2); PG8_BAR;
        PG8_STAGE(PG8_SB(1, 0), cB + kstep, voffB); PG8_STAGE(PG8_SA(1, 0), cA + kstep, voffA); PG8_STAGE(PG8_SB(1, 1), cB + hstep + kstep, voffB);
        PG8_WAIT_V(6); PG8_BAR;
    } else {
        PG8_STAGE(PG8_SB(0, 0), cB, voffB); PG8_STAGE(PG8_SA(0, 0), cA, voffA); PG8_STAGE(PG8_SB(0, 1), cB + hstep, voffB); PG8_STAGE(PG8_SA(0, 1), cA + hstep, voffA);
        if (wr == 1) PG8_BAR;
        PG8_WAIT_V(4); PG8_BAR;
        PG8_STAGE(PG8_SB(1, 0), cB + kstep, voffB); PG8_STAGE(PG8_SA(1, 0), cA + kstep, voffA); PG8_STAGE(PG8_SB(1, 1), cB + hstep + kstep, voffB);
        PG8_WAIT_V(6); PG8_BAR;
    }
    for (;;) {
        const bool has_next = S.next(ui + 1, nxt);
        const char* nA = has_next ? (const char*)g.A + (size_t)nxt.pm * tstep + (size_t)nxt.koff * 2 : cA; const char* nB = has_next ? (const char*)g.Bt + (size_t)nxt.pn * tstep + (size_t)nxt.koff * 2 : cB;
        const int nt = cur.nt;
        for (int t = 0; t < nt; t += 2) {
            const bool last = (t == nt - 2);
            const char* a1 = cA + (size_t)(t + 1) * kstep;
            const char* a2 = last ? nA : cA + (size_t)(t + 2) * kstep; const char* b2 = last ? nB : cB + (size_t)(t + 2) * kstep;
            const char* a3 = a2 + kstep; const char* b3 = b2 + kstep;
            if (last && has_next) S.a_ready(nxt);
            if constexpr (SP2) {
            PG8_LDB(B0, 0, 0); PG8_LDB(B1, 0, 1); PG8_SCHED; PG8_LDA(At, 0, 0); PG8_STAGE(PG8_SA(1, 1), a1 + hstep, voffA);
            PG8_WAIT_V(8); PG8_WAIT_L(0); PG8_BAR; PG8_MMA(0, 0, At, B0); PG8_MMA(0, 1, At, B1); PG8_BAR; PG8_SCHED;
            PG8_LDA(At, 0, 1); PG8_STAGE(PG8_SB(0, 0), b2, voffB); PG8_STAGE(PG8_SB(0, 1), b2 + hstep, voffB); PG8_STAGE(PG8_SA(0, 0), a2, voffA);
            PG8_WAIT_V(8); PG8_WAIT_L(0); PG8_BAR; PG8_MMA(1, 0, At, B0); PG8_MMA(1, 1, At, B1); PG8_BAR; PG8_SCHED;
            PG8_LDB(B0, 1, 0); PG8_LDB(B1, 1, 1); PG8_SCHED; PG8_LDA(At, 1, 0); PG8_STAGE(PG8_SA(0, 1), a2 + hstep, voffA);
            PG8_WAIT_V(8); PG8_WAIT_L(0); PG8_BAR; PG8_MMA(0, 0, At, B0); PG8_MMA(0, 1, At, B1); PG8_BAR; PG8_SCHED;
            PG8_LDA(At, 1, 1); PG8_STAGE(PG8_SB(1, 0), b3, voffB); PG8_STAGE(PG8_SB(1, 1), b3 + hstep, voffB); PG8_STAGE(PG8_SA(1, 0), a3, voffA);
            PG8_WAIT_V(8); PG8_WAIT_L(0); PG8_BAR; PG8_MMA(1, 0, At, B0); PG8_MMA(1, 1, At, B1); PG8_BAR; PG8_SCHED;
            } else {
            PG8_LDB(B0, 0, 0); PG8_SCHED; PG8_LDA(At, 0, 0); PG8_STAGE(PG8_SA(1, 1), a1 + hstep, voffA);
            PG8_WAIT_L(8); PG8_BAR; PG8_WAIT_L(0); PG8_MMA(0, 0, At, B0); PG8_BAR; PG8_SCHED;
            PG8_LDB(B1, 0, 1); PG8_STAGE(PG8_SB(0, 0), b2, voffB);
            PG8_BAR; PG8_WAIT_L(0); PG8_MMA(0, 1, At, B1); PG8_BAR;
            PG8_LDA(At, 0, 1); PG8_STAGE(PG8_SA(0, 0), a2, voffA);
            PG8_BAR; PG8_WAIT_L(0); PG8_MMA(1, 0, At, B0); PG8_BAR; PG8_SCHED;
            PG8_STAGE(PG8_SB(0, 1), b2 + hstep, voffB);
            PG8_WAIT_V(6); PG8_BAR; PG8_MMA(1, 1, At, B1); PG8_BAR;
            PG8_LDB(B0, 1, 0); PG8_SCHED; PG8_LDA(At, 1, 0); PG8_STAGE(PG8_SA(0, 1), a2 + hstep, voffA);
            PG8_WAIT_L(8); PG8_BAR; PG8_WAIT_L(0); PG8_MMA(0, 0, At, B0); PG8_BAR; PG8_SCHED;
            PG8_LDB(B1, 1, 1); PG8_STAGE(PG8_SB(1, 0), b3, voffB);
            PG8_BAR; PG8_WAIT_L(0); PG8_MMA(0, 1, At, B1); PG8_BAR;
            PG8_LDA(At, 1, 1); PG8_STAGE(PG8_SA(1, 0), a3, voffA);
            PG8_BAR; PG8_WAIT_L(0); PG8_MMA(1, 0, At, B0); PG8_BAR; PG8_SCHED;
            PG8_STAGE(PG8_SB(1, 1), b3 + hstep, voffB);
            PG8_WAIT_V(6); PG8_BAR; PG8_MMA(1, 1, At, B1); PG8_BAR;
            }
        }
        if constexpr (ALIGN_EPI) { if (wr == 0) PG8_BAR; }
        if constexpr (!Epi::AFTER_DRAIN) { E(acc, cur, wr, wc, fr, fq); S.done(cur); }
        if (!has_next) break;
#pragma unroll
        for (int a = 0; a < 2; ++a)
#pragma unroll
            for (int b = 0; b < 2; ++b)
#pragma unroll
                for (int m = 0; m < 4; ++m)
#pragma unroll
                    for (int n = 0; n < 2; ++n) acc[a][b][m][n] = (f32x4){0.f, 0.f, 0.f, 0.f};
        cur = nxt; cA = nA; cB = nB; ++ui;
        if constexpr (ALIGN_EPI) { if (wr == 1) PG8_BAR; }
    }
    PG8_WAIT_V(0);
    if constexpr (!ALIGN_EPI) { if (wr == 0) PG8_BAR; }
    PG8_BAR;
    if constexpr (Epi::AFTER_DRAIN) { E.fused(acc, cur, wr, wc, fr, fq, lds, wid, lane); S.done(cur); }
#undef PG8_SA
#undef PG8_SB
#undef PG8_STAGE
#undef PG8_LDA
#undef PG8_LDB
#undef PG8_MMA
#undef PG8_WAIT_V
#undef PG8_WAIT_L
#undef PG8_BAR
#undef PG8_SCHED
}
}

#ifndef PG8_SP2
#define PG8_SP2 true
#endif
#ifndef PG8_ALIGN
#define PG8_ALIGN true
#endif

constexpr int NWAVES = 8;
#ifndef MK_N_LAUNCHES
#define MK_N_LAUNCHES 1
#endif
constexpr int PER_PHASE = 13;
constexpr int N_LAUNCHES = MK_N_LAUNCHES;

constexpr int MP = 16384, MS = 256, M = MP + MS;
constexpr int D = 1024, FF = 2816, DIN = 3072, DC = 512, NH = 4, HD = 128, TP = 8192, TS = 32, CWID = 31, PAST = 4096;
constexpr float EPS = 1e-6f;
constexpr size_t O_Y = 0, O_CP = (size_t)M * D, O_RP = O_CP + 2 * 30 * DC, O_CS = O_RP + 2 * NH * HD * HD, O_RS = O_CS + 8 * 30 * DC, O_END = O_RS + 8 * NH * HD * HD;
static_assert(O_END == 17848320, "output size");

constexpr size_t MiB = 1u << 20;
constexpr size_t WS_CTL = 0, CTL_ZERO_BYTES = 1 * MiB;
constexpr size_t WS_WGU1 = 1 * MiB, WS_WD1 = 12 * MiB, WS_WIN = WS_WD1 + 5632 * 1024, WS_WOUT = WS_WIN + 6 * MiB, WS_WGU2 = WS_WOUT + 2 * MiB, WS_WD2 = WS_WGU2 + 11 * MiB;
constexpr size_t WS_H = 42 * MiB;
constexpr size_t WS_ACT = 75 * MiB;
constexpr size_t WS_F = 173 * MiB;
constexpr size_t WS_SLAB = 238 * MiB;
constexpr size_t WS_END = WS_SLAB + (size_t)4 * 256 * DIN * 4;
constexpr int NKS_DOWN = 11, NKS_IN = 4, NKS_OUT = 4;
static_assert(WS_WD2 + (size_t)D * FF * 2 <= WS_H && WS_H + (size_t)M * D * 2 <= WS_ACT && WS_ACT + (size_t)M * DIN * 2 <= WS_F && WS_F + (size_t)M * D * 4 <= WS_SLAB && (size_t)NKS_DOWN * 256 * D * 4 <= WS_END - WS_SLAB && WS_END <= 256 * MiB, "d_ws map");
constexpr int CW_BAR = 4096;

constexpr int RING_OFF = 0, RING_BYTES = 131072;
constexpr int LDSCTL_OFF = RING_BYTES, MISC_OFF = LDSCTL_OFF + 320;
constexpr int LDS_BYTES = 147456;
static_assert(MISC_OFF + 128 <= LDS_BYTES, "LDS map");
#define GAS __attribute__((address_space(1)))
#define LAS __attribute__((address_space(3)))
typedef unsigned short bf16;
typedef unsigned v4u __attribute__((ext_vector_type(4)));
typedef float f32x4 __attribute__((ext_vector_type(4)));
typedef short bf16x8 __attribute__((ext_vector_type(8)));
typedef GAS unsigned gu32;
typedef GAS unsigned long long gu64;
#define RLX_AGENT __ATOMIC_RELAXED, __HIP_MEMORY_SCOPE_AGENT
#define LDS_WAIT() asm volatile("s_waitcnt lgkmcnt(0)" ::: "memory")
#define VM_WAIT() asm volatile("s_waitcnt vmcnt(0)" ::: "memory")
__device__ __forceinline__ unsigned long long rt() { return __builtin_amdgcn_s_memrealtime(); }
__device__ __forceinline__ unsigned f2bf(float f) { unsigned u = __builtin_bit_cast(unsigned, f); return (u + 0x7fffu + ((u >> 16) & 1u)) >> 16; }
__device__ __forceinline__ unsigned pk2(float lo, float hi) { return f2bf(lo) | (f2bf(hi) << 16); }

#define XB_TMO      128
#define XB_XCNT(j)  (256  + 64 * (j))
#define XB_XSUB(j)  (1280 + 64 * (j))
#define XB_XGEN(j)  (2304 + 64 * (j))
#define XB_TOP      3328
#define XB_TOPGEN   3392
#define XCD_BAR_WORDS 3456
#define XB_SPIN_CAP (1u << 18)

__device__ __forceinline__ unsigned xb_ld(unsigned* p)              { return __hip_atomic_load(p, __ATOMIC_RELAXED, __HIP_MEMORY_SCOPE_AGENT); }
__device__ __forceinline__ unsigned xb_add(unsigned* p, unsigned v) { return __hip_atomic_fetch_add(p, v, __ATOMIC_RELAXED, __HIP_MEMORY_SCOPE_AGENT); }
__device__ __forceinline__ unsigned xb_xcc_id() { return (unsigned)__builtin_amdgcn_s_getreg((3 << 11) | 20) & 0xFu; }
#define XB_SPIN(cond, bar) do { unsigned _sp = 0; while (cond) { __builtin_amdgcn_s_sleep(1); \
    if ((++_sp & 255u) == 0u) { if (xb_ld(&(bar)[XB_TMO])) break; if (_sp > XB_SPIN_CAP) { atomicAdd(&(bar)[XB_TMO], 1u); break; } } } } while (0)

struct XcdBarrier {
    unsigned* bar; unsigned x;
    volatile LAS unsigned* st;
};

__device__ __forceinline__ XcdBarrier xcd_barrier_post(unsigned* bar, volatile LAS unsigned* st) {
    XcdBarrier b; b.bar = bar; b.x = xb_xcc_id(); b.st = st;
    if (threadIdx.x == 0) (void)xb_add(&bar[XB_XCNT(b.x)], 1u);
    return b;
}
__device__ __forceinline__ void xcd_barrier_complete(unsigned* bar, unsigned x, unsigned& nloc, unsigned& nx) {
    const unsigned G = gridDim.x * gridDim.y * gridDim.z;
    unsigned sum, cnt, mine, sp = 0u;
    for (;;) {
        sum = 0u; cnt = 0u; mine = 0u;
#pragma unroll
        for (unsigned j = 0; j < 16; ++j) { const unsigned c = xb_ld(&bar[XB_XCNT(j)]); sum += c; cnt += (c > 0u) ? 1u : 0u; mine = (j == x) ? c : mine; }
        if (sum == G) break;
        __builtin_amdgcn_s_sleep(1);
        if ((++sp & 255u) == 0u) { if (xb_ld(&bar[XB_TMO])) break; if (sp > XB_SPIN_CAP) { atomicAdd(&bar[XB_TMO], 1u); break; } }
    }
    nloc = mine > 0u ? mine : 1u; nx = cnt > 0u ? cnt : 1u;
}

__device__ __forceinline__ void xcd_barrier(const XcdBarrier& b) {
    asm volatile("s_waitcnt vmcnt(0)" ::: "memory");
    __syncthreads();
    if (threadIdx.x == 0) {
        unsigned* bar = b.bar;
        __builtin_amdgcn_s_waitcnt(0);
        unsigned nloc = b.st[0], nx = b.st[1];
        if (nloc == 0u) { xcd_barrier_complete(bar, b.x, nloc, nx); b.st[0] = nloc; b.st[1] = nx; }
        const unsigned old = xb_add(&bar[XB_XSUB(b.x)], 1u);
        const unsigned gen = old / nloc;
        if (old + 1u == (gen + 1u) * nloc) {
            __builtin_amdgcn_fence(__ATOMIC_RELEASE, "agent");
            asm volatile("s_waitcnt vmcnt(0)" ::: "memory");
            const unsigned og = xb_add(&bar[XB_TOP], 1u);
            const unsigned tg = og / nx;
            if (og + 1u == (tg + 1u) * nx) xb_add(&bar[XB_TOPGEN], 1u);
            else XB_SPIN(xb_ld(&bar[XB_TOPGEN]) == tg, bar);
            __builtin_amdgcn_fence(__ATOMIC_ACQUIRE, "agent");
            xb_add(&bar[XB_XGEN(b.x)], 1u);
            asm volatile("s_waitcnt vmcnt(0)" ::: "memory");
        } else {
            XB_SPIN(xb_ld(&bar[XB_XGEN(b.x)]) == gen, bar);
            __builtin_amdgcn_fence(__ATOMIC_ACQUIRE, "agent");
            asm volatile("s_waitcnt vmcnt(0)" ::: "memory");
        }
    }
    __syncthreads();
}


typedef float f32x2 __attribute__((ext_vector_type(2)));
typedef unsigned u32x2 __attribute__((ext_vector_type(2)));
__device__ __forceinline__ float wave_sum(float v) {
#pragma unroll
    for (int o = 1; o < 64; o <<= 1) v += __shfl_xor(v, o);
    return v;
}
__device__ __forceinline__ float bf_lo(unsigned w) { return __builtin_bit_cast(float, w << 16); }
__device__ __forceinline__ float bf_hi(unsigned w) { return __builtin_bit_cast(float, w & 0xffff0000u); }
__device__ __forceinline__ float bf1(bf16 b) { return __builtin_bit_cast(float, (unsigned)b << 16); }
__device__ __forceinline__ float sigmoidf_(float x) { return 1.0f / (1.0f + __expf(-x)); }

__device__ __forceinline__ void p0_transpose_item(const float* W, int K, int N, bf16* WT, int mode, LAS float* scr, int item, int lane) {
    const int nblk = N / 32, kb = item / nblk, nb = item % nblk, k0 = 64 * kb, n0 = 32 * nb;
#pragma unroll 8
    for (int i = 0; i < 32; ++i) { const int kk = 2 * i + (lane >> 5); scr[kk * 33 + (lane & 31)] = W[(size_t)(k0 + kk) * N + n0 + (lane & 31)]; }
    LDS_WAIT(); asm volatile("" ::: "memory");
    const int r0 = (mode == 0) ? n0 : ((n0 >> 7) * 256 + (n0 & 127) + (mode == 2 ? 128 : 0));
    const int c = lane & 7;
#pragma unroll
    for (int j = 0; j < 4; ++j) { const int n = (lane >> 3) + 8 * j; const LAS float* s = scr + (8 * c) * 33 + n;
        v4u o; o.x = pk2(s[0 * 33], s[1 * 33]); o.y = pk2(s[2 * 33], s[3 * 33]); o.z = pk2(s[4 * 33], s[5 * 33]); o.w = pk2(s[6 * 33], s[7 * 33]);
        *(GAS v4u*)(WT + (size_t)(r0 + n) * K + k0 + 8 * c) = o; }
    LDS_WAIT(); asm volatile("" ::: "memory");
}
__device__ __forceinline__ void rms_row_to_bf16(const float* xrow, const float* gain, bf16* orow, int lane) {
    const GAS f32x4* xr = (const GAS f32x4*)xrow + lane; const GAS f32x4* gr = (const GAS f32x4*)gain + lane;
    f32x4 v[4]; float s = 0.f;
#pragma unroll
    for (int j = 0; j < 4; ++j) { v[j] = xr[64 * j]; s += (v[j].x * v[j].x + v[j].y * v[j].y) + (v[j].z * v[j].z + v[j].w * v[j].w); }
    const float rstd = 1.f / sqrtf(wave_sum(s) * (1.f / D) + EPS);
    GAS unsigned long long* o8 = (GAS unsigned long long*)orow + lane;
#pragma unroll
    for (int j = 0; j < 4; ++j) { const f32x4 g = gr[64 * j];
        o8[64 * j] = (unsigned long long)pk2(v[j].x * rstd * g.x, v[j].y * rstd * g.y) | ((unsigned long long)pk2(v[j].z * rstd * g.z, v[j].w * rstd * g.w) << 32); }
}

__device__ __forceinline__ void norm_row(const float* frow, int nsl, size_t sl_stride, const float* xrow, float scale, const float* gpost, float* yrow, const float* gnext, bf16* hrow, int lane) {
    const GAS f32x4* fr_ = (const GAS f32x4*)frow + lane; const GAS f32x4* xr = (const GAS f32x4*)xrow + lane; const GAS f32x4* gp = (const GAS f32x4*)gpost + lane;
    f32x4 f[4], x[4]; float s = 0.f;
#pragma unroll
    for (int j = 0; j < 4; ++j) { f[j] = fr_[64 * j]; x[j] = xr[64 * j]; }
    for (int k = 1; k < nsl; ++k) {
#pragma unroll
        for (int j = 0; j < 4; ++j) f[j] = f[j] + fr_[k * (sl_stride / 4) + 64 * j]; }
#pragma unroll
    for (int j = 0; j < 4; ++j) s += (f[j].x * f[j].x + f[j].y * f[j].y) + (f[j].z * f[j].z + f[j].w * f[j].w);
    const float rf = scale / sqrtf(wave_sum(s) * (1.f / D) + EPS);
    float s2 = 0.f;
    GAS f32x4* yo = (GAS f32x4*)yrow + lane;
#pragma unroll
    for (int j = 0; j < 4; ++j) { const f32x4 g = gp[64 * j]; x[j] = x[j] + f[j] * g * rf; yo[64 * j] = x[j];
        s2 += (x[j].x * x[j].x + x[j].y * x[j].y) + (x[j].z * x[j].z + x[j].w * x[j].w); }
    if (gnext) {
        const float rstd = 1.f / sqrtf(wave_sum(s2) * (1.f / D) + EPS);
        const GAS f32x4* gn = (const GAS f32x4*)gnext + lane; GAS unsigned long long* o8 = (GAS unsigned long long*)hrow + lane;
#pragma unroll
        for (int j = 0; j < 4; ++j) { const f32x4 g = gn[64 * j];
            o8[64 * j] = (unsigned long long)pk2(x[j].x * rstd * g.x, x[j].y * rstd * g.y) | ((unsigned long long)pk2(x[j].z * rstd * g.z, x[j].w * rstd * g.w) << 32); }
    }
}

constexpr int CS_LD = 516, US_LD = 520, C_US = 32 * CS_LD * 4;
static_assert(C_US + 62 * US_LD * 2 <= RING_BYTES, "conv LDS map");
__device__ __forceinline__ float rcp_sigmoid(float x) { return __builtin_amdgcn_rcpf(1.0f + __expf(-x)); }
__device__ __forceinline__ void conv_unit(LAS unsigned char* lds, int cu, const bf16* P, const float* state_conv, const float* conv_w, const float* conv_b,
                                          const float* ln_g, const float* ln_b, bf16* MIX, float* out, int tid, int lane, int wave) {
    const bool smp = cu >= 512; const int b = smp ? cu - 512 : cu >> 8, T0 = smp ? 0 : (cu & 255) * 32;
    const size_t rb = smp ? (size_t)MP + b * TS : (size_t)b * TP;
    const bool tail = smp || (cu & 255) == 255;
    float* nh = out + (smp ? O_CS : O_CP) + (size_t)b * 30 * DC;
    LAS bf16* us = (LAS bf16*)(lds + C_US); LAS float* cs = (LAS float*)lds;
    {
        v4u ra[8], rg[8];
#pragma unroll
        for (int k = 0; k < 8; ++k) { const int it = tid + 512 * k, ee = it >> 6, c8 = it & 63, ts = T0 + ee - 30;
            ra[k] = (v4u){0u, 0u, 0u, 0u}; rg[k] = ra[k];
            if (ee < 62) {
                if (ts >= 0) { const GAS bf16* pr = (const GAS bf16*)(P + (rb + ts) * DIN) + 8 * c8; ra[k] = *(const GAS v4u*)pr; rg[k] = *(const GAS v4u*)(pr + DC); }
                else if (smp) { const GAS f32x4* hp = (const GAS f32x4*)(state_conv + ((size_t)b * 30 + (30 + ts)) * DC + 8 * c8); ra[k] = __builtin_bit_cast(v4u, hp[0]); rg[k] = __builtin_bit_cast(v4u, hp[1]); }
            } }
#pragma unroll
        for (int k = 0; k < 8; ++k) { const int it = tid + 512 * k, ee = it >> 6, c8 = it & 63, ts = T0 + ee - 30;
            if (ee < 62) {
                float u[8];
                if (ts >= 0) {
#pragma unroll
                    for (int i = 0; i < 4; ++i) { u[2 * i] = bf_lo(ra[k][i]) * rcp_sigmoid(bf_lo(rg[k][i])); u[2 * i + 1] = bf_hi(ra[k][i]) * rcp_sigmoid(bf_hi(rg[k][i])); }
                } else {
                    const f32x4 h0 = __builtin_bit_cast(f32x4, ra[k]), h1 = __builtin_bit_cast(f32x4, rg[k]);
                    u[0] = h0.x; u[1] = h0.y; u[2] = h0.z; u[3] = h0.w; u[4] = h1.x; u[5] = h1.y; u[6] = h1.z; u[7] = h1.w;
                }
                v4u o; o.x = pk2(u[0], u[1]); o.y = pk2(u[2], u[3]); o.z = pk2(u[4], u[5]); o.w = pk2(u[6], u[7]);
                *(LAS v4u*)(us + ee * US_LD + 8 * c8) = o;
                if (tail && ee >= 32) { GAS f32x4* np = (GAS f32x4*)(nh + (size_t)(ee - 32) * DC + 8 * c8); np[0] = (f32x4){u[0], u[1], u[2], u[3]}; np[1] = (f32x4){u[4], u[5], u[6], u[7]}; }
            } }
    }
    __syncthreads();
    {
        const int ch = tid;
        float w[CWID], acc[32];
#pragma unroll
        for (int j = 0; j < CWID; ++j) w[j] = conv_w[j * DC + ch];
        const float bias = conv_b[ch];
#pragma unroll
        for (int t = 0; t < 32; ++t) acc[t] = bias;
#pragma unroll
        for (int ee = 0; ee < 62; ++ee) { const float v = bf1(us[ee * US_LD + ch]);
#pragma unroll
            for (int t = 0; t < 32; ++t) { const int j = ee - t; if (j >= 0 && j < CWID) acc[t] += w[j] * v; } }
#pragma unroll
        for (int t = 0; t < 32; ++t) cs[t * CS_LD + ch] = acc[t];
    }
    __syncthreads();
    const f32x4 g0 = ((const GAS f32x4*)ln_g)[2 * lane], g1 = ((const GAS f32x4*)ln_g)[2 * lane + 1], b0 = ((const GAS f32x4*)ln_b)[2 * lane], b1 = ((const GAS f32x4*)ln_b)[2 * lane + 1];
#pragma unroll
    for (int tt = 0; tt < 4; ++tt) { const int t = wave * 4 + tt;
        f32x4 x0 = *(const LAS f32x4*)(cs + t * CS_LD + 8 * lane), x1 = *(const LAS f32x4*)(cs + t * CS_LD + 8 * lane + 4);
        const float mean = wave_sum((x0.x + x0.y) + (x0.z + x0.w) + (x1.x + x1.y) + (x1.z + x1.w)) * (1.f / DC);
        x0 = x0 - mean; x1 = x1 - mean;
        const float var = wave_sum((x0.x * x0.x + x0.y * x0.y) + (x0.z * x0.z + x0.w * x0.w) + (x1.x * x1.x + x1.y * x1.y) + (x1.z * x1.z + x1.w * x1.w)) * (1.f / DC);
        const float rstd = 1.f / sqrtf(var + EPS);
        x0 = x0 * rstd * g0 + b0; x1 = x1 * rstd * g1 + b1;
        v4u o; o.x = pk2(x0.x * rcp_sigmoid(x0.x), x0.y * rcp_sigmoid(x0.y)); o.y = pk2(x0.z * rcp_sigmoid(x0.z), x0.w * rcp_sigmoid(x0.w));
        o.z = pk2(x1.x * rcp_sigmoid(x1.x), x1.y * rcp_sigmoid(x1.y)); o.w = pk2(x1.z * rcp_sigmoid(x1.z), x1.w * rcp_sigmoid(x1.w));
        *(GAS v4u*)(MIX + (rb + T0 + t) * D + 8 * lane) = o; }
    __syncthreads();
}

constexpr int R_QS = 0, R_KS = 17408, R_KZT = 34816, R_VT = 53248, R_RT = 71680, R_SS = 106496, R_OS = 0;
constexpr int QS_LD = 136, KT_LD = 72, RT_LD = 136, SS_LD = 72, OS_LD = 132;
static_assert(R_SS + 64 * SS_LD * 2 <= RING_BYTES && 64 * OS_LD * 4 <= R_KZT, "retention LDS map");
struct RetCtx { const bf16* P; size_t row0; int pos0, C, h; float lg; };
struct RetRegs { v4u k1, k2, v1, v2, q1, q2; unsigned gate[8]; };

template <bool WITH_Q>
__device__ __forceinline__ void ret_load(RetRegs& r, const RetCtx& c, int tid, int lane, int wave) {
    const int j = tid >> 3, cc = tid & 7; const bool valid = j < c.C;
    const GAS bf16* prow = (const GAS bf16*)(c.P + (c.row0 + (valid ? j : 0)) * DIN) + c.h * HD + 8 * cc;
    r.k1 = *(const GAS v4u*)(prow + 1536); r.k2 = *(const GAS v4u*)(prow + 1536 + 64); r.v1 = *(const GAS v4u*)(prow + 2048); r.v2 = *(const GAS v4u*)(prow + 2048 + 64);
    if (WITH_Q) { r.q1 = *(const GAS v4u*)(prow + 1024); r.q2 = *(const GAS v4u*)(prow + 1024 + 64);
#pragma unroll
        for (int tt = 0; tt < 8; ++tt) { const int i = 8 * wave + tt; r.gate[tt] = *(const GAS unsigned*)(c.P + (c.row0 + (i < c.C ? i : 0)) * DIN + 2560 + c.h * HD + 2 * lane); } }
}
template <bool WITH_Q>
__device__ __forceinline__ void ret_write(LAS unsigned char* lds, const RetRegs& r, const RetCtx& c, int tid) {
    const int j = tid >> 3, cc = tid & 7; const bool valid = j < c.C;
    float kf1[8], kf2[8], qf1[8], qf2[8]; v4u v1 = r.v1, v2 = r.v2;
#pragma unroll
    for (int i = 0; i < 4; ++i) { kf1[2 * i] = bf_lo(r.k1[i]); kf1[2 * i + 1] = bf_hi(r.k1[i]); kf2[2 * i] = bf_lo(r.k2[i]); kf2[2 * i + 1] = bf_hi(r.k2[i]); }
    if (WITH_Q) {
#pragma unroll
        for (int i = 0; i < 4; ++i) { qf1[2 * i] = bf_lo(r.q1[i]); qf1[2 * i + 1] = bf_hi(r.q1[i]); qf2[2 * i] = bf_lo(r.q2[i]); qf2[2 * i + 1] = bf_hi(r.q2[i]); } }
    if (!valid) { v1 = v2 = (v4u){0u, 0u, 0u, 0u};
#pragma unroll
        for (int i = 0; i < 8; ++i) { kf1[i] = kf2[i] = 0.f; if (WITH_Q) { qf1[i] = qf2[i] = 0.f; } } }
    float cs[8], sn[8]; const float pos = (float)(c.pos0 + j);
#pragma unroll
    for (int i = 0; i < 8; ++i) { const float inv = exp2f((float)(8 * cc + i) * (-13.287712379549449f / 64.0f)); const float ang = pos * inv;
        const float n = rintf(ang * 0.15915494309189535f); float rr = fmaf(-n, 6.2831854820251465f, ang); rr = fmaf(-n, -1.7484555e-07f, rr);
        const float rev = rr * 0.15915494309189535f; cs[i] = __builtin_amdgcn_cosf(rev); sn[i] = __builtin_amdgcn_sinf(rev); }
    const float z = valid ? __expf(c.lg * (float)(c.C - 1 - j)) : 0.f;
    const float KS = 0.08838834764831845f;
    float r1[8], r2[8];
#pragma unroll
    for (int i = 0; i < 8; ++i) { r1[i] = (kf1[i] * cs[i] - kf2[i] * sn[i]) * KS; r2[i] = (kf2[i] * cs[i] + kf1[i] * sn[i]) * KS; }
    LAS bf16* KzT = (LAS bf16*)(lds + R_KZT); LAS bf16* VT = (LAS bf16*)(lds + R_VT);
#pragma unroll
    for (int i = 0; i < 8; ++i) { KzT[(8 * cc + i) * KT_LD + j] = (bf16)f2bf(r1[i] * z); KzT[(64 + 8 * cc + i) * KT_LD + j] = (bf16)f2bf(r2[i] * z); }
#pragma unroll
    for (int i = 0; i < 4; ++i) { VT[(8 * cc + 2 * i) * KT_LD + j] = (bf16)(v1[i] & 0xffffu); VT[(8 * cc + 2 * i + 1) * KT_LD + j] = (bf16)(v1[i] >> 16);
                                  VT[(64 + 8 * cc + 2 * i) * KT_LD + j] = (bf16)(v2[i] & 0xffffu); VT[(64 + 8 * cc + 2 * i + 1) * KT_LD + j] = (bf16)(v2[i] >> 16); }
    if (WITH_Q) {
        LAS bf16* Ks = (LAS bf16*)(lds + R_KS); LAS bf16* Qs = (LAS bf16*)(lds + R_QS);
        v4u o; o.x = pk2(r1[0], r1[1]); o.y = pk2(r1[2], r1[3]); o.z = pk2(r1[4], r1[5]); o.w = pk2(r1[6], r1[7]); *(LAS v4u*)(Ks + j * QS_LD + 8 * cc) = o;
        o.x = pk2(r2[0], r2[1]); o.y = pk2(r2[2], r2[3]); o.z = pk2(r2[4], r2[5]); o.w = pk2(r2[6], r2[7]); *(LAS v4u*)(Ks + j * QS_LD + 64 + 8 * cc) = o;
#pragma unroll
        for (int i = 0; i < 8; ++i) { r1[i] = qf1[i] * cs[i] - qf2[i] * sn[i]; r2[i] = qf2[i] * cs[i] + qf1[i] * sn[i]; }
        o.x = pk2(r1[0], r1[1]); o.y = pk2(r1[2], r1[3]); o.z = pk2(r1[4], r1[5]); o.w = pk2(r1[6], r1[7]); *(LAS v4u*)(Qs + j * QS_LD + 8 * cc) = o;
        o.x = pk2(r2[0], r2[1]); o.y = pk2(r2[2], r2[3]); o.z = pk2(r2[4], r2[5]); o.w = pk2(r2[6], r2[7]); *(LAS v4u*)(Qs + j * QS_LD + 64 + 8 * cc) = o;
    }
}
#define MFMA16(a, b, c) __builtin_amdgcn_mfma_f32_16x16x32_bf16((a), (b), (c), 0, 0, 0)
__device__ __forceinline__ void ret_update(LAS unsigned char* lds, f32x4 (&racc)[8], float gch, int w, int fr, int fq) {
    const LAS bf16* KzT = (const LAS bf16*)(lds + R_KZT); const LAS bf16* VT = (const LAS bf16*)(lds + R_VT);
#pragma unroll
    for (int vb = 0; vb < 8; ++vb) racc[vb] = racc[vb] * gch;
#pragma unroll
    for (int ks = 0; ks < 2; ++ks) { const bf16x8 a = *(const LAS bf16x8*)(KzT + (16 * w + fr) * KT_LD + 32 * ks + 8 * fq);
#pragma unroll
        for (int vb = 0; vb < 8; ++vb) { const bf16x8 bb = *(const LAS bf16x8*)(VT + (16 * vb + fr) * KT_LD + 32 * ks + 8 * fq); racc[vb] = MFMA16(a, bb, racc[vb]); } }
}
__device__ __forceinline__ void ret_write_rt(LAS unsigned char* lds, const f32x4 (&racc)[8], int w, int fr, int fq) {
    LAS bf16* RT = (LAS bf16*)(lds + R_RT);
#pragma unroll
    for (int vb = 0; vb < 8; ++vb) { u32x2 o; o.x = pk2(racc[vb][0], racc[vb][1]); o.y = pk2(racc[vb][2], racc[vb][3]); *(LAS u32x2*)(RT + (16 * vb + fr) * RT_LD + 16 * w + 4 * fq) = o; }
}
__device__ __forceinline__ void ret_pass_a(LAS unsigned char* lds, const bf16* P, int unit, float* AGG, int tid, int lane, int wave) {
    const int b = unit >> 7, h = (unit >> 5) & 3, grp = unit & 31, fr = lane & 15, fq = lane >> 4;
    const float lg = log1pf(-exp2f(-5.0f - (float)h)), gch = __expf(lg * 64.f);
    f32x4 racc[8];
#pragma unroll
    for (int vb = 0; vb < 8; ++vb) racc[vb] = (f32x4){0.f, 0.f, 0.f, 0.f};
    RetRegs rg;
    { RetCtx c{P, (size_t)b * TP + (size_t)(grp * 4) * 64, (grp * 4) * 64, 64, h, lg}; ret_load<false>(rg, c, tid, lane, wave); }
#pragma unroll 1
    for (int ci = 0; ci < 4; ++ci) {
        float lgl = lg; int tl = tid; asm volatile("" : "+v"(lgl), "+v"(tl));
        RetCtx c{P, (size_t)b * TP + (size_t)(grp * 4 + ci) * 64, (grp * 4 + ci) * 64, 64, h, lgl};
        ret_write<false>(lds, rg, c, tl);
        __syncthreads();
        if (ci < 3) { RetCtx cn{P, c.row0 + 64, c.pos0 + 64, 64, h, lg}; ret_load<false>(rg, cn, tid, lane, wave); }
        ret_update(lds, racc, gch, wave, fr, fq);
        __syncthreads();
    }
    float* o = AGG + (size_t)unit * (HD * HD);
#pragma unroll
    for (int vb = 0; vb < 8; ++vb)
#pragma unroll
        for (int r = 0; r < 4; ++r) ((GAS float*)o)[(16 * wave + 4 * fq + r) * HD + 16 * vb + fr] = racc[vb][r];
}
__device__ __forceinline__ void ret_pass_b(LAS unsigned char* lds, const bf16* P, int unit, bool smp, const float* RIN, const float* state_ret, const float* gn_g, bf16* MIX, float* out,
                                           int tid, int lane, int wave) {
    const int b = smp ? unit >> 2 : unit >> 7, h = smp ? unit & 3 : (unit >> 5) & 3, grp = smp ? 0 : unit & 31, fr = lane & 15, fq = lane >> 4, w = wave;
    const int C = smp ? TS : 64, nch = smp ? 1 : 4;
    const float lg = log1pf(-exp2f(-5.0f - (float)h)), gch = __expf(lg * (float)C);
    const size_t rowA = smp ? (size_t)MP + b * TS : (size_t)b * TP + (size_t)(grp * 4) * 64; const int posA = smp ? PAST : (grp * 4) * 64;
    RetRegs rg;
    { RetCtx c{P, rowA, posA, C, h, lg}; ret_load<true>(rg, c, tid, lane, wave); }
    f32x4 racc[8];
    { const GAS float* s = smp ? (const GAS float*)state_ret + (size_t)(b * NH + h) * (HD * HD) : (const GAS float*)RIN + (size_t)unit * (HD * HD);
#pragma unroll
        for (int vb = 0; vb < 8; ++vb)
#pragma unroll
            for (int r = 0; r < 4; ++r) racc[vb][r] = s[(16 * w + 4 * fq + r) * HD + 16 * vb + fr]; }
    ret_write_rt(lds, racc, w, fr, fq);
    const LAS bf16* Qs = (const LAS bf16*)(lds + R_QS); const LAS bf16* Ks = (const LAS bf16*)(lds + R_KS); const LAS bf16* VT = (const LAS bf16*)(lds + R_VT);
    const LAS bf16* RT = (const LAS bf16*)(lds + R_RT); LAS bf16* Ss = (LAS bf16*)(lds + R_SS); LAS float* Os = (LAS float*)(lds + R_OS);
    const f32x2 gg = *(const GAS f32x2*)(gn_g + h * HD + 2 * lane);
#pragma unroll 1
    for (int ci = 0; ci < nch; ++ci) {
        const size_t row0 = rowA + (size_t)ci * 64;
        float lgl = lg; int tl = tid; asm volatile("" : "+v"(lgl), "+v"(tl));
        RetCtx c{P, row0, posA + ci * 64, C, h, lgl};
        ret_write<true>(lds, rg, c, tl);
        unsigned gate[8];
#pragma unroll
        for (int tt = 0; tt < 8; ++tt) gate[tt] = rg.gate[tt];
        __syncthreads();
        if (ci + 1 < nch) { RetCtx cn{P, row0 + 64, c.pos0 + 64, C, h, lg}; ret_load<true>(rg, cn, tid, lane, wave); }
        {
            const int ib = w >> 1, jb0 = 2 * (w & 1);
            f32x4 sacc[2] = {(f32x4){0.f, 0.f, 0.f, 0.f}, (f32x4){0.f, 0.f, 0.f, 0.f}};
#pragma unroll
            for (int ks = 0; ks < 4; ++ks) { const bf16x8 a = *(const LAS bf16x8*)(Qs + (16 * ib + fr) * QS_LD + 32 * ks + 8 * fq);
#pragma unroll
                for (int t = 0; t < 2; ++t) { const bf16x8 bb = *(const LAS bf16x8*)(Ks + (16 * (jb0 + t) + fr) * QS_LD + 32 * ks + 8 * fq); sacc[t] = MFMA16(a, bb, sacc[t]); } }
#pragma unroll
            for (int t = 0; t < 2; ++t) { const int j = 16 * (jb0 + t) + fr;
#pragma unroll
                for (int r = 0; r < 4; ++r) { const int i = 16 * ib + 4 * fq + r; const float v = (i >= j) ? sacc[t][r] * __expf(lgl * (float)(i - j)) : 0.f; Ss[i * SS_LD + j] = (bf16)f2bf(v); } }
        }
        __syncthreads();
        f32x4 oacc[4];
#pragma unroll
        for (int ib = 0; ib < 4; ++ib) oacc[ib] = (f32x4){0.f, 0.f, 0.f, 0.f};
#pragma unroll
        for (int ks = 0; ks < 4; ++ks) { const bf16x8 bb = *(const LAS bf16x8*)(RT + (16 * w + fr) * RT_LD + 32 * ks + 8 * fq);
#pragma unroll
            for (int ib = 0; ib < 4; ++ib) { const bf16x8 a = *(const LAS bf16x8*)(Qs + (16 * ib + fr) * QS_LD + 32 * ks + 8 * fq); oacc[ib] = MFMA16(a, bb, oacc[ib]); } }
#pragma unroll
        for (int ib = 0; ib < 4; ++ib)
#pragma unroll
            for (int r = 0; r < 4; ++r) oacc[ib][r] *= __expf(lgl * (float)(16 * ib + 4 * fq + r + 1));
#pragma unroll
        for (int ks = 0; ks < 2; ++ks) { const bf16x8 bb = *(const LAS bf16x8*)(VT + (16 * w + fr) * KT_LD + 32 * ks + 8 * fq);
#pragma unroll
            for (int ib = 0; ib < 4; ++ib) { const bf16x8 a = *(const LAS bf16x8*)(Ss + (16 * ib + fr) * SS_LD + 32 * ks + 8 * fq); oacc[ib] = MFMA16(a, bb, oacc[ib]); } }
        __syncthreads();
#pragma unroll
        for (int ib = 0; ib < 4; ++ib)
#pragma unroll
            for (int r = 0; r < 4; ++r) Os[(16 * ib + 4 * fq + r) * OS_LD + 16 * w + fr] = oacc[ib][r];
        ret_update(lds, racc, gch, w, fr, fq);
        ret_write_rt(lds, racc, w, fr, fq);
        __syncthreads();
        {
#pragma unroll
            for (int tt = 0; tt < 8; ++tt) { const int i = 8 * w + tt;
                if (i < C) {
                    f32x2 x = *(const LAS f32x2*)(Os + i * OS_LD + 2 * lane);
                    const float mu = wave_sum(x.x + x.y) * (1.f / HD); x = x - mu;
                    const float var = wave_sum(x.x * x.x + x.y * x.y) * (1.f / HD), rstd = 1.f / sqrtf(var + EPS);
                    const float g0 = bf_lo(gate[tt]), g1 = bf_hi(gate[tt]);
                    *(GAS unsigned*)(MIX + (row0 + i) * D + DC + h * HD + 2 * lane) = pk2(x.x * rstd * gg.x * (g0 * rcp_sigmoid(g0)), x.y * rstd * gg.y * (g1 * rcp_sigmoid(g1)));
                } }
        }
        __syncthreads();
    }
    if (smp || grp == 31) {
        float* o = out + (smp ? O_RS : O_RP) + (size_t)(b * NH + h) * (HD * HD);
#pragma unroll
        for (int vb = 0; vb < 8; ++vb)
#pragma unroll
            for (int r = 0; r < 4; ++r) ((GAS float*)o)[(16 * w + 4 * fq + r) * HD + 16 * vb + fr] = racc[vb][r];
    }
}

struct Args { const float* in[23]; float* out; unsigned char* ws; int ph_lo, ph_hi, li, pad; };
#define CAS __attribute__((address_space(4)))
__device__ __forceinline__ const CAS unsigned char* karg_base() { const CAS unsigned char* kp = (const CAS unsigned char*)__builtin_amdgcn_kernarg_segment_ptr(); asm volatile("" : "+s"(kp)); return kp; }
__device__ __forceinline__ const float* karg_in(int i) { return *(const float* const CAS*)(karg_base() + 8 * i); }
__device__ __forceinline__ float* karg_out() { return *(float* const CAS*)(karg_base() + 8 * 23); }
__device__ __forceinline__ unsigned char* karg_ws() { return *(unsigned char* const CAS*)(karg_base() + 8 * 24); }
__device__ __forceinline__ int karg_lo() { return *(const CAS int*)(karg_base() + 200); }
__device__ __forceinline__ int karg_hi() { return *(const CAS int*)(karg_base() + 204); }
#define PHASE_IDS() int tid = threadIdx.x; asm volatile("" : "+v"(tid)); const int lane = tid & 63, wave = __builtin_amdgcn_readfirstlane(tid >> 6); \
    const int G = gridDim.x, bx = blockIdx.x; (void)lane; (void)wave; (void)G; (void)bx
#define PHASE_GW() const int vcu = (G % 8 == 0) ? (bx % 8) * (G / 8) + bx / 8 : bx; const int gw = vcu * NWAVES + wave, NGW = G * NWAVES

__device__ __forceinline__ void ph_prologue(LAS unsigned char* lds) {
    PHASE_IDS(); PHASE_GW();
    unsigned char* ws = karg_ws();
    LAS float* scr = (LAS float*)(lds + RING_OFF + wave * 16384);
    constexpr int I_GU = (D / 64) * (FF / 32), I_DN = (FF / 64) * (D / 32), I_IN = (D / 64) * (DIN / 32), I_OUT = (D / 64) * (D / 32);
    constexpr int NITEMS = 4 * I_GU + 2 * I_DN + I_IN + I_OUT;
    for (int it = gw; it < NITEMS; it += NGW) {
        int r = it;
        if (r < I_GU) { p0_transpose_item(karg_in(5), D, FF, (bf16*)(ws + WS_WGU1), 1, scr, r, lane); continue; } r -= I_GU;
        if (r < I_GU) { p0_transpose_item(karg_in(6), D, FF, (bf16*)(ws + WS_WGU1), 2, scr, r, lane); continue; } r -= I_GU;
        if (r < I_DN) { p0_transpose_item(karg_in(7), FF, D, (bf16*)(ws + WS_WD1), 0, scr, r, lane); continue; } r -= I_DN;
        if (r < I_IN) { p0_transpose_item(karg_in(10), D, DIN, (bf16*)(ws + WS_WIN), 0, scr, r, lane); continue; } r -= I_IN;
        if (r < I_OUT) { p0_transpose_item(karg_in(16), D, D, (bf16*)(ws + WS_WOUT), 0, scr, r, lane); continue; } r -= I_OUT;
        if (r < I_GU) { p0_transpose_item(karg_in(19), D, FF, (bf16*)(ws + WS_WGU2), 1, scr, r, lane); continue; } r -= I_GU;
        if (r < I_GU) { p0_transpose_item(karg_in(20), D, FF, (bf16*)(ws + WS_WGU2), 2, scr, r, lane); continue; } r -= I_GU;
        p0_transpose_item(karg_in(21), FF, D, (bf16*)(ws + WS_WD2), 0, scr, r, lane);
    }
    const float* xp = karg_in(0); const float* xs = karg_in(1); const float* g = karg_in(4); bf16* Hb = (bf16*)(ws + WS_H);
    for (int m = gw; m < M; m += NGW) rms_row_to_bf16(m < MP ? xp + (size_t)m * D : xs + (size_t)(m - MP) * D, g, Hb + (size_t)m * D, lane);
}
template <int IT> __device__ __forceinline__ void ph_gateup(LAS unsigned char* lds) {
    unsigned char* ws = karg_ws();
    pg8::Gemm g{(const bf16*)(ws + WS_H), (const bf16*)(ws + (IT ? WS_WGU2 : WS_WGU1)), M, 2 * FF, D}; pg8::StaticOrder S; S.init(MP, 2 * FF, D, (int)gridDim.x, (int)blockIdx.x); S.extra(MP / 256, 1);
    pg8::EpiSwiglu E{(bf16*)(ws + WS_ACT), FF};
    pg8::gemm_phase<pg8::EpiSwiglu, pg8::StaticOrder, PG8_ALIGN, PG8_SP2>(lds + RING_OFF, g, S, E);
}
template <int IT> __device__ __forceinline__ void ph_down(LAS unsigned char* lds) {
    unsigned char* ws = karg_ws();
    pg8::Gemm g{(const bf16*)(ws + WS_ACT), (const bf16*)(ws + (IT ? WS_WD2 : WS_WD1)), M, D, FF}; pg8::StaticOrder S; S.init(MP, D, FF, (int)gridDim.x, (int)blockIdx.x); S.extra(MP / 256, NKS_DOWN);
    pg8::EpiF32 E{(float*)(ws + WS_F), D, (float*)(ws + WS_SLAB)};
    pg8::gemm_phase<pg8::EpiF32, pg8::StaticOrder, PG8_ALIGN, PG8_SP2>(lds + RING_OFF, g, S, E);
}
template <int WHICH> __device__ __forceinline__ void ph_norm() {
    PHASE_IDS(); PHASE_GW();
    unsigned char* ws = karg_ws(); float* Y = karg_out() + O_Y; const float* Fb = (const float*)(ws + WS_F); bf16* Hb = (bf16*)(ws + WS_H);
    const float* gpost = karg_in(WHICH == 0 ? 8 : (WHICH == 1 ? 17 : 22)); const float* gnext = WHICH == 2 ? nullptr : karg_in(WHICH == 0 ? 9 : 18);
    const float* xp = karg_in(0); const float* xs = karg_in(1);
    for (int m = gw; m < M; m += NGW) {
        const float* xr = WHICH == 0 ? (m < MP ? xp + (size_t)m * D : xs + (size_t)(m - MP) * D) : (const float*)(Y + (size_t)m * D);
        const bool smp = m >= MP; const float* fr = smp ? (const float*)(ws + WS_SLAB) + (size_t)(m - MP) * D : Fb + (size_t)m * D;
        norm_row(fr, smp ? (WHICH == 1 ? NKS_OUT : NKS_DOWN) : 1, (size_t)256 * D, xr, WHICH == 1 ? 1.0f : 0.5f, gpost, Y + (size_t)m * D, gnext, Hb + (size_t)m * D, lane);
    }
}
__device__ __forceinline__ void ph_win(LAS unsigned char* lds) {
    unsigned char* ws = karg_ws();
    pg8::Gemm g{(const bf16*)(ws + WS_H), (const bf16*)(ws + WS_WIN), M, DIN, D}; pg8::StaticOrder S; S.init(MP, DIN, D, (int)gridDim.x, (int)blockIdx.x); S.extra(MP / 256, NKS_IN);
    pg8::EpiBf16 E{(bf16*)(ws + WS_ACT), DIN, (float*)(ws + WS_SLAB)};
    pg8::gemm_phase<pg8::EpiBf16, pg8::StaticOrder, PG8_ALIGN, PG8_SP2>(lds + RING_OFF, g, S, E);
}
__device__ __forceinline__ void ph_wout(LAS unsigned char* lds) {
    unsigned char* ws = karg_ws();
    pg8::Gemm g{(const bf16*)(ws + WS_H), (const bf16*)(ws + WS_WOUT), M, D, D}; pg8::StaticOrder S; S.init(MP, D, D, (int)gridDim.x, (int)blockIdx.x); S.extra(MP / 256, NKS_OUT);
    pg8::EpiF32 E{(float*)(ws + WS_F), D, (float*)(ws + WS_SLAB)};
    pg8::gemm_phase<pg8::EpiF32, pg8::StaticOrder, PG8_ALIGN, PG8_SP2>(lds + RING_OFF, g, S, E);
}
__device__ __forceinline__ void ph_mix1(LAS unsigned char* lds) {
    PHASE_IDS();
    unsigned char* ws = karg_ws(); const bf16* Pb = (const bf16*)(ws + WS_ACT);
    for (int r = bx; r < MS; r += G) {
        const GAS float* sl = (const GAS float*)(ws + WS_SLAB) + (size_t)r * DIN; GAS bf16* o = (GAS bf16*)(ws + WS_ACT) + (size_t)(MP + r) * DIN;
#pragma unroll
        for (int k = 0; k < 3; ++k) { const int col = 2 * tid + 1024 * k; f32x2 a = *(const GAS f32x2*)(sl + col);
#pragma unroll
            for (int q = 1; q < NKS_IN; ++q) a = a + *(const GAS f32x2*)(sl + (size_t)q * 256 * DIN + col);
            *(GAS unsigned*)(o + col) = pk2(a.x, a.y); }
    }
    if ((bx & 31) != 31) ret_pass_a(lds, Pb, bx, (float*)(ws + WS_F), tid, lane, wave);
    for (int cu = bx; cu < 512; cu += G) conv_unit(lds, cu, Pb, karg_in(2), karg_in(11), karg_in(12), karg_in(13), karg_in(14), (bf16*)(ws + WS_H), karg_out(), tid, lane, wave);
}
__device__ __forceinline__ void ph_mix2(LAS unsigned char* lds) {
    PHASE_IDS();
    unsigned char* ws = karg_ws();
#pragma unroll 1
    for (int k = 0; k < 2; ++k) {
        if (k == 1 && bx >= 32) break;
        ret_pass_b(lds, (const bf16*)(ws + WS_ACT), bx, k == 1, (const float*)(ws + WS_F), karg_in(3), karg_in(15), (bf16*)(ws + WS_H), karg_out(), tid, lane, wave);
    }
    if (bx >= 32 && bx < 40) conv_unit(lds, 512 + bx - 32, (const bf16*)(ws + WS_ACT), karg_in(2), karg_in(11), karg_in(12), karg_in(13), karg_in(14), (bf16*)(ws + WS_H), karg_out(), tid, lane, wave);
}

__device__ __forceinline__ void ph_scan() {
    PHASE_IDS();
    GAS float* A = (GAS float*)(karg_ws() + WS_F) + (size_t)(bx >> 5) * 32 * (HD * HD) + (size_t)(bx & 31) * 512 + tid;
    const float lg = log1pf(-exp2f(-5.0f - (float)((bx >> 5) & 3))), g4 = __expf(lg * 256.f);
    float a[31];
#pragma unroll
    for (int g = 0; g < 31; ++g) a[g] = A[(size_t)g * (HD * HD)];
    float r = 0.f; A[0] = 0.f;
#pragma unroll
    for (int g = 1; g < 32; ++g) { r = r * g4 + a[g - 1]; A[(size_t)g * (HD * HD)] = r; }
}
__global__ void __launch_bounds__(NWAVES * 64, 2) mk_fwd(Args args) {
    extern __shared__ __attribute__((aligned(16))) unsigned char lds_raw[];
    LAS unsigned char* lds = (LAS unsigned char*)lds_raw;
    volatile LAS unsigned* MISC = (volatile LAS unsigned*)(lds + MISC_OFF);
    for (int u = threadIdx.x; u < (LDS_BYTES - LDSCTL_OFF) / 4; u += NWAVES * 64) ((LAS unsigned*)(lds + LDSCTL_OFF))[u] = 0u;
    __syncthreads();
    gu32* ctl = (gu32*)(karg_ws() + WS_CTL);
    XcdBarrier bar; bar.bar = (unsigned*)(ctl + CW_BAR); bar.x = 0; bar.st = nullptr;
    if (N_LAUNCHES != PER_PHASE) bar = xcd_barrier_post((unsigned*)(ctl + CW_BAR), MISC + 8);
#define IN(k) (karg_lo() <= (k) && (k) < karg_hi())
#define SEAM(k) do { if (N_LAUNCHES != PER_PHASE && IN(k) && IN((k) + 1)) xcd_barrier(bar); } while (0)
#ifndef PROBE_DUP
#define PROBE_DUP -1
#endif
#define DUP(k, call) do { if (PROBE_DUP == (k)) { call; xcd_barrier(bar); } } while (0)
    if (IN(0)) { DUP(0, ph_prologue(lds)); ph_prologue(lds); SEAM(0); }
    if (IN(1)) { DUP(1, ph_gateup<0>(lds)); ph_gateup<0>(lds); SEAM(1); }
    if (IN(2)) { DUP(2, ph_down<0>(lds)); ph_down<0>(lds); SEAM(2); }
    if (IN(3)) { DUP(3, ph_norm<0>()); ph_norm<0>(); SEAM(3); }
    if (IN(4)) { DUP(4, ph_win(lds)); ph_win(lds); SEAM(4); }
    if (IN(5)) { DUP(5, ph_mix1(lds)); ph_mix1(lds); SEAM(5); }
    if (IN(6)) { ph_scan(); SEAM(6); }
    if (IN(7)) { DUP(7, ph_mix2(lds)); ph_mix2(lds); SEAM(7); }
    if (IN(8)) { DUP(8, ph_wout(lds)); ph_wout(lds); SEAM(8); }
    if (IN(9)) { ph_norm<1>(); SEAM(9); }
    if (IN(10)) { ph_gateup<1>(lds); SEAM(10); }
    if (IN(11)) { ph_down<1>(lds); SEAM(11); }
    if (IN(12)) { ph_norm<2>(); }
#undef IN
#undef SEAM
    (void)args;
}

extern "C" void kernel_launch(void* const* d_in, const int* in_sizes, int n_in, void* d_out, int out_size, void* d_ws, size_t ws_size, hipStream_t stream) {
    static int grid = 0;
    if (grid == 0) {
        if (n_in != 23 || in_sizes[0] != MP * D || out_size != (int)O_END || ws_size < WS_END) { fprintf(stderr, "kernel_launch: unexpected shapes: n_in %d in0 %d out %d ws %zu; nothing launched\n", n_in, n_in > 0 ? in_sizes[0] : -1, out_size, ws_size); grid = -1; return; }
        int dev = 0, cus = 0, per_cu = 0;
        if (hipGetDevice(&dev) != hipSuccess || hipDeviceGetAttribute(&cus, hipDeviceAttributeMultiprocessorCount, dev) != hipSuccess) { fprintf(stderr, "kernel_launch: device query failed\n"); grid = -1; return; }
        if (hipFuncSetAttribute((const void*)mk_fwd, hipFuncAttributeMaxDynamicSharedMemorySize, LDS_BYTES) != hipSuccess) { fprintf(stderr, "kernel_launch: hipFuncSetAttribute failed\n"); grid = -1; return; }
        if (hipOccupancyMaxActiveBlocksPerMultiprocessor(&per_cu, (const void*)mk_fwd, NWAVES * 64, LDS_BYTES) != hipSuccess || per_cu < 1)
            fprintf(stderr, "kernel_launch: note: occupancy query reports %d workgroups per CU\n", per_cu);
        (void)hipGetLastError();
        grid = cus;
        if (grid != 256) fprintf(stderr, "kernel_launch: %d CUs; this kernel is laid out for 256\n", grid);
    }
    if (grid < 0) return;
    if (hipMemsetAsync((char*)d_ws + WS_CTL, 0, CTL_ZERO_BYTES, stream) != hipSuccess) { fprintf(stderr, "kernel_launch: hipMemsetAsync failed\n"); return; }
    Args a{};
    for (int i = 0; i < 23; ++i) a.in[i] = (const float*)d_in[i];
    a.out = (float*)d_out; a.ws = (unsigned char*)d_ws;
    for (int li = 0; li < N_LAUNCHES; ++li) {
        a.ph_lo = (N_LAUNCHES == PER_PHASE) ? li : 0; a.ph_hi = (N_LAUNCHES == PER_PHASE) ? li + 1 : PER_PHASE; a.li = li;
        hipLaunchKernelGGL(mk_fwd, dim3(grid), dim3(NWAVES * 64), LDS_BYTES, stream, a);
        const hipError_t le = hipPeekAtLastError();
        if (le != hipSuccess) { fprintf(stderr, "kernel_launch: launch %d failed: %s\n", li, hipGetErrorName(le)); break; }
    }
}
```
